# Optimizing an MI355X kernel written in HIP

```python
import math
import jax, jax.numpy as jnp
from jax import lax
import numpy as np

D_MODEL = 2048
BATCH = 1
SEQ = 8192
DEPTH = 2

D_SSM = D_MODEL // 2
SSM_GROUP = 16
N_SSM_GROUPS = D_SSM // SSM_GROUP
SSM_STATE = 64
N_DIR = 2
D_ATTN = D_MODEL // 2
N_HEADS = 8
HEAD_DIM = D_ATTN // (2 * N_HEADS)
ROT_DIM = HEAD_DIM // 4
ROPE_THETA = 500000.0
Q_BLOCK = 128
N_BRANCH = 2
IN_COLS = D_SSM + 3 * D_ATTN + N_BRANCH * D_MODEL
N_EXPERTS = 16
D_EXPERT = 1024
CAPACITY_FACTOR = 2
EPS = 1e-6

kernel_name = "hybrid_s5_diffattn_ec_moe_encoder"


def rms_norm(x, g):
    xf = x.astype(jnp.float32)
    y = xf * lax.rsqrt(jnp.mean(xf * xf, axis=-1, keepdims=True) + EPS) * g.astype(jnp.float32)
    return y.astype(x.dtype)


def lambda_init_for(layer_idx):
    return 0.8 - 0.6 * math.exp(-0.3 * layer_idx)


def rope_tables(seq_len):
    pos = jnp.arange(seq_len, dtype=jnp.float32)
    inv = jnp.power(ROPE_THETA, -jnp.arange(0, ROT_DIM, 2, dtype=jnp.float32) / ROT_DIM)
    ang = pos[:, None] * inv[None, :]
    return jnp.cos(ang), jnp.sin(ang)


def apply_partial_rope(x, cos, sin):
    half = ROT_DIM // 2
    c = cos[None, :, None, None, :].astype(x.dtype)
    s = sin[None, :, None, None, :].astype(x.dtype)
    x1 = x[..., :half]
    x2 = x[..., half:ROT_DIM]
    rot = jnp.concatenate([x1 * c - x2 * s, x2 * c + x1 * s], axis=-1)
    return jnp.concatenate([rot, x[..., ROT_DIM:]], axis=-1)


def _ssm_combine(e1, e2):
    a1, b1 = e1
    a2, b2 = e2
    return a1 * a2, a2 * b1 + b2


def s5_bidirectional(u, a_re, a_im, log_step, b_re, b_im, c_re, c_im, d_skip):
    B, L, _ = u.shape
    f32 = jnp.float32
    uf = u.astype(f32)
    ug = uf.reshape(B, L, N_SSM_GROUPS, SSM_GROUP).astype(jnp.complex64)
    lam = lax.complex(a_re.astype(f32), a_im.astype(f32))
    step = jnp.exp(log_step.astype(f32))[..., None]
    lam_bar = jnp.exp(lam * step)
    b_bar = ((lam_bar - 1.0) / lam)[..., None] * lax.complex(b_re.astype(f32), b_im.astype(f32))
    c = lax.complex(c_re.astype(f32), c_im.astype(f32))
    y = d_skip.astype(f32) * uf
    for direction in range(N_DIR):
        bu = jnp.einsum('blgh,gph->blgp', ug, b_bar[direction])
        a = jnp.broadcast_to(lam_bar[direction], bu.shape)
        _, states = lax.associative_scan(_ssm_combine, (a, bu), reverse=(direction == 1), axis=1)
        y = y + jnp.real(jnp.einsum('blgp,ghp->blgh', states, c[direction])).reshape(B, L, D_SSM)
    return y.astype(u.dtype)


def diff_attention(q, k, v, q_g, k_g, lq1, lk1, lq2, lk2, sub_g, lam_init, cos, sin):
    B, L, _ = q.shape
    q = q.reshape(B, L, N_HEADS, 2, HEAD_DIM)
    k = k.reshape(B, L, N_HEADS, 2, HEAD_DIM)
    v = v.reshape(B, L, N_HEADS, 2 * HEAD_DIM)
    q = apply_partial_rope(rms_norm(q, q_g), cos, sin) * (HEAD_DIM ** -0.5)
    k = apply_partial_rope(rms_norm(k, k_g), cos, sin)
    f32 = jnp.float32
    lam = (jnp.exp(jnp.sum(lq1.astype(f32) * lk1.astype(f32)))
           - jnp.exp(jnp.sum(lq2.astype(f32) * lk2.astype(f32))) + lam_init)
    nb = L // Q_BLOCK
    qb = q.reshape(B, nb, Q_BLOCK, N_HEADS, 2, HEAD_DIM).transpose(1, 0, 3, 4, 2, 5)
    kt = k.transpose(0, 2, 3, 1, 4)
    vt = v.transpose(0, 2, 1, 3)

    def block(q_blk):
        s = jnp.einsum('bhcqd,bhckd->bhcqk', q_blk, kt).astype(f32)
        p = jax.nn.softmax(s, axis=-1)
        a = p[:, :, 0] - lam * p[:, :, 1]
        return jnp.einsum('bhqk,bhkv->bhqv', a.astype(vt.dtype), vt)

    o = lax.map(block, qb)
    o = o.transpose(1, 0, 3, 2, 4).reshape(B, L, N_HEADS, 2 * HEAD_DIM)
    o = rms_norm(o, sub_g) * (1.0 - lam_init)
    return o.reshape(B, L, D_ATTN)


def expert_choice_moe(x, w_router, w_gate, w_up, w_down):
    B, T, D = x.shape
    cap = max(1, CAPACITY_FACTOR * T // N_EXPERTS)
    logits = jnp.einsum('btd,de->bte', x, w_router).astype(jnp.float32)
    aff = jax.nn.softmax(logits, axis=-1)
    gate, idx = lax.top_k(aff.transpose(0, 2, 1), cap)
    xe = jax.vmap(lambda xb, ib: xb[ib])(x, idx)
    h = jax.nn.silu(jnp.einsum('becd,edf->becf', xe, w_gate)) * jnp.einsum('becd,edf->becf', xe, w_up)
    ye = jnp.einsum('becf,efd->becd', h, w_down) * gate[..., None].astype(x.dtype)
    return jax.vmap(lambda yb, ib: jnp.zeros((T, D), yb.dtype).at[ib.reshape(-1)].add(yb.reshape(-1, D)))(ye, idx)


def setup_inputs(seed: int = 0) -> dict:
    key = jax.random.key(seed)
    ks = jax.random.split(key, 32)
    f32 = jnp.float32
    G, P, H = N_SSM_GROUPS, SSM_STATE, SSM_GROUP

    def nrm(k, shape, scale):
        return jax.random.normal(k, shape, f32) * scale

    def gain(k, shape):
        return 1.0 + 0.02 * jax.random.normal(k, shape, f32)

    n_idx = jnp.arange(P, dtype=f32)
    a_re = -0.5 + 0.01 * jax.random.normal(ks[3], (DEPTH, N_DIR, G, P), f32)
    a_im = math.pi * n_idx + 0.01 * jax.random.normal(ks[4], (DEPTH, N_DIR, G, P), f32)
    log_step = jax.random.uniform(ks[5], (DEPTH, N_DIR, G), f32, math.log(1e-3), math.log(1e-1))
    return {
        "x": jax.random.normal(ks[0], (BATCH, SEQ, D_MODEL), f32),
        "mix_norm_g": gain(ks[1], (DEPTH, D_MODEL)),
        "w_in": nrm(ks[2], (DEPTH, D_MODEL, IN_COLS), D_MODEL ** -0.5),
        "gate_b": nrm(ks[6], (DEPTH, N_BRANCH, D_MODEL), 0.01),
        "ssm_a_re": a_re,
        "ssm_a_im": a_im,
        "ssm_log_step": log_step,
        "ssm_b_re": nrm(ks[7], (DEPTH, N_DIR, G, P, H), (2 * H) ** -0.5),
        "ssm_b_im": nrm(ks[8], (DEPTH, N_DIR, G, P, H), (2 * H) ** -0.5),
        "ssm_c_re": nrm(ks[9], (DEPTH, N_DIR, G, H, P), P ** -0.5),
        "ssm_c_im": nrm(ks[10], (DEPTH, N_DIR, G, H, P), P ** -0.5),
        "ssm_d": nrm(ks[11], (DEPTH, D_SSM), 1.0),
        "w_glu": nrm(ks[12], (DEPTH, D_SSM, D_SSM), D_SSM ** -0.5),
        "q_norm_g": gain(ks[13], (DEPTH, HEAD_DIM)),
        "k_norm_g": gain(ks[14], (DEPTH, HEAD_DIM)),
        "lambda_q1": nrm(ks[15], (DEPTH, HEAD_DIM), 0.1),
        "lambda_k1": nrm(ks[16], (DEPTH, HEAD_DIM), 0.1),
        "lambda_q2": nrm(ks[17], (DEPTH, HEAD_DIM), 0.1),
        "lambda_k2": nrm(ks[18], (DEPTH, HEAD_DIM), 0.1),
        "subln_g": gain(ks[19], (DEPTH, 2 * HEAD_DIM)),
        "w_br_ssm": nrm(ks[20], (DEPTH, D_SSM, D_MODEL), D_SSM ** -0.5),
        "w_br_attn": nrm(ks[21], (DEPTH, D_ATTN, D_MODEL), D_ATTN ** -0.5),
        "w_out": nrm(ks[22], (DEPTH, D_MODEL, D_MODEL), D_MODEL ** -0.5),
        "ffn_norm_g": gain(ks[23], (DEPTH, D_MODEL)),
        "w_router": nrm(ks[24], (DEPTH, D_MODEL, N_EXPERTS), D_MODEL ** -0.5),
        "w_e_gate": nrm(ks[25], (DEPTH, N_EXPERTS, D_MODEL, D_EXPERT), D_MODEL ** -0.5),
        "w_e_up": nrm(ks[26], (DEPTH, N_EXPERTS, D_MODEL, D_EXPERT), D_MODEL ** -0.5),
        "w_e_down": nrm(ks[27], (DEPTH, N_EXPERTS, D_EXPERT, D_MODEL), D_EXPERT ** -0.5),
    }


def reference(x, mix_norm_g, w_in, gate_b, ssm_a_re, ssm_a_im, ssm_log_step, ssm_b_re, ssm_b_im,
              ssm_c_re, ssm_c_im, ssm_d, w_glu, q_norm_g, k_norm_g, lambda_q1, lambda_k1,
              lambda_q2, lambda_k2, subln_g, w_br_ssm, w_br_attn, w_out, ffn_norm_g, w_router,
              w_e_gate, w_e_up, w_e_down):
    B, L, _ = x.shape
    cos, sin = rope_tables(L)
    splits = [D_SSM, D_SSM + D_ATTN, D_SSM + 2 * D_ATTN, D_SSM + 3 * D_ATTN]
    for l in range(DEPTH):
        lam_init = lambda_init_for(l)
        h = rms_norm(x, mix_norm_g[l])
        proj = h @ w_in[l]
        u_ssm, q, k, v, gate_logits = jnp.split(proj, splits, axis=-1)
        y_s = s5_bidirectional(u_ssm, ssm_a_re[l], ssm_a_im[l], ssm_log_step[l], ssm_b_re[l],
                               ssm_b_im[l], ssm_c_re[l], ssm_c_im[l], ssm_d[l])
        y_s = jax.nn.gelu(y_s)
        y_s = y_s * jax.nn.sigmoid(y_s @ w_glu[l])
        y_a = diff_attention(q, k, v, q_norm_g[l], k_norm_g[l], lambda_q1[l], lambda_k1[l],
                             lambda_q2[l], lambda_k2[l], subln_g[l], lam_init, cos, sin)
        g = jax.nn.sigmoid((gate_logits.reshape(B, L, N_BRANCH, D_MODEL) + gate_b[l]).astype(jnp.float32)).astype(x.dtype)
        merged = g[:, :, 0] * (y_s @ w_br_ssm[l]) + g[:, :, 1] * (y_a @ w_br_attn[l])
        x = x + merged @ w_out[l]
        x = x + expert_choice_moe(rms_norm(x, ffn_norm_g[l]), w_router[l], w_e_gate[l],
                                  w_e_up[l], w_e_down[l])
    return x
```

```cpp
#include <hip/hip_runtime.h>
#include <cstdio>
#include <cstdint>
__device__ __forceinline__ int lane_id_asm() { int x; asm volatile("v_mbcnt_lo_u32_b32 %0, -1, 0\n\tv_mbcnt_hi_u32_b32 %0, -1, %0" : "=v"(x)); return x; }
namespace pg8 {
#define PG8_LAS __attribute__((address_space(3)))
typedef unsigned short bf16_t;
typedef short bf16x8 __attribute__((ext_vector_type(8)));
typedef float f32x4 __attribute__((ext_vector_type(4)));
typedef unsigned u32x4 __attribute__((ext_vector_type(4)));
constexpr int BM = 256, BK = 64, HALF = 128, HTB = HALF * BK * 2  , STAGE_BYTES = 8 * HTB, NXCD = 8, WGM = 8;

__host__ __device__ __forceinline__ int lds_byte(int r, int c) { const int st = (r >> 4) * 2 + (c >> 5), rr = r & 15, cc = c & 31, ob = rr * 64 + cc * 2; return st * 1024 + (ob ^ (((ob >> 9) & 1) << 5)); }
__host__ __device__ __forceinline__ void stage_rc(int b, int& R, int& C) { const int st = b / 1024, sb = b % 1024, swz = sb ^ (((sb >> 9) & 1) << 5); R = (st >> 1) * 16 + swz / 64; C = (st & 1) * 32 + (swz % 64) / 2; }
__host__ __device__ __forceinline__ int perm32(int rho) { const int n = rho >> 4, i = rho & 15; return 8 * (i >> 2) + 4 * n + (i & 3); }

struct Unit { int pm, pn, pb; };
struct Gemm { const bf16_t* A; const bf16_t* Bt; int M, N, K; };

struct StaticOrder {
    int nM, nN, nwg, G, c;
    __host__ __device__ void init(int M, int N, int G_, int c_) { nM = M / BM; nN = N / BM; nwg = nM * nN; G = G_; c = c_; }
    __host__ __device__ bool next(int i, Unit& u) const {
        const long L = (long)i * G + c; if (L >= nwg) return false;
        int wgid = (int)L; { const int q = nwg / NXCD, r = nwg % NXCD, xcd = wgid % NXCD, off = wgid / NXCD; wgid = (xcd < r ? xcd * (q + 1) : r * (q + 1) + (xcd - r) * q) + off; }
        const int nig = WGM * nN, gid = wgid / nig, fm = gid * WGM, gsz = (nM - fm) < WGM ? (nM - fm) : WGM;
        u.pm = fm + ((wgid % nig) % gsz); u.pn = (wgid % nig) / gsz; u.pb = u.pn; return true;
    }
    __device__ __forceinline__ void a_ready(const Unit&) const {}
    __device__ __forceinline__ void done(const Unit&) const {}
};


typedef float f32x2_t __attribute__((ext_vector_type(2))); typedef __bf16 bf16x2_t __attribute__((ext_vector_type(2)));
__device__ __forceinline__ unsigned cvt_pk_bf16(float lo, float hi) { f32x2_t v = {lo, hi}; bf16x2_t b = __builtin_convertvector(v, bf16x2_t); return __builtin_bit_cast(unsigned, b); }
__device__ __forceinline__ float bflo(unsigned w) { return __uint_as_float(w << 16); }
__device__ __forceinline__ float bfhi(unsigned w) { return __uint_as_float(w & 0xffff0000u); }
__device__ __forceinline__ float sigm(float x) { return __builtin_amdgcn_rcpf(1.f + __builtin_amdgcn_exp2f(-1.4426950408889634f * x)); }
__device__ __forceinline__ u32x4 pack8(const f32x4& v0, const f32x4& v1) { u32x4 w; w.x = cvt_pk_bf16(v0[0], v0[1]); w.y = cvt_pk_bf16(v0[2], v0[3]); w.z = cvt_pk_bf16(v1[0], v1[1]); w.w = cvt_pk_bf16(v1[2], v1[3]); return w; }

struct EpiInProj {
    static constexpr bool PERM = true, AFTER_DRAIN = false;
    bf16_t *U, *Q, *Kk, *V, *G; const float* gate_b;
    __device__ __forceinline__ void operator()(const f32x4 (&acc)[2][2][4][2], const Unit& u, int wr, int wc, int fr, int fq) const {
        const int row0 = u.pm * BM + wr * 64 + fr, ct = u.pn * BM, lc = wc * 32 + 8 * fq;
        if (ct < 1024) {
            const int c0 = ct + lc;
            bf16_t* gb0 = U + ((size_t)(c0 >> 4) * 8192) * 16 + (c0 & 15); bf16_t* gb1 = U + ((size_t)((c0 + HALF) >> 4) * 8192) * 16 + (c0 & 15);
#pragma unroll
            for (int ai = 0; ai < 2; ++ai)
#pragma unroll
                for (int m = 0; m < 4; ++m) { const size_t ro = (size_t)(row0 + ai * HALF + m * 16) * 16;
                    *(u32x4*)(gb0 + ro) = pack8(acc[ai][0][m][0], acc[ai][0][m][1]); *(u32x4*)(gb1 + ro) = pack8(acc[ai][1][m][0], acc[ai][1][m][1]); }
        } else if (ct < 4096) {
            bf16_t* base = Q + (size_t)((ct >> 10) - 1) * (8u << 20);
            const int c0 = (ct & 1023) + lc;
#pragma unroll
            for (int ai = 0; ai < 2; ++ai)
#pragma unroll
                for (int m = 0; m < 4; ++m) { bf16_t* rowp = base + (size_t)(row0 + ai * HALF + m * 16) * 1024 + c0;
#pragma unroll
                    for (int bj = 0; bj < 2; ++bj) *(u32x4*)(rowp + bj * HALF) = pack8(acc[ai][bj][m][0], acc[ai][bj][m][1]); }
        } else {
            const int c0 = ct - 4096 + lc;
            f32x4 bv[2][2];
#pragma unroll
            for (int bj = 0; bj < 2; ++bj)
#pragma unroll
                for (int n = 0; n < 2; ++n) bv[bj][n] = *(const f32x4*)(gate_b + c0 + bj * HALF + 4 * n);
#pragma unroll
            for (int ai = 0; ai < 2; ++ai)
#pragma unroll
                for (int m = 0; m < 4; ++m) { bf16_t* rowp = G + (size_t)(row0 + ai * HALF + m * 16) * 4096 + c0;
#pragma unroll
                    for (int bj = 0; bj < 2; ++bj) { f32x4 v0 = acc[ai][bj][m][0] + bv[bj][0], v1 = acc[ai][bj][m][1] + bv[bj][1];
#pragma unroll
                        for (int j = 0; j < 4; ++j) { v0[j] = sigm(v0[j]); v1[j] = sigm(v1[j]); }
                        *(u32x4*)(rowp + bj * HALF) = pack8(v0, v1); } }
        }
    }
};
struct EpiGlu {
    static constexpr bool PERM = true, AFTER_DRAIN = false;
    const bf16_t* YS; bf16_t* O;
    __device__ __forceinline__ void operator()(const f32x4 (&acc)[2][2][4][2], const Unit& u, int wr, int wc, int fr, int fq) const {
        const int row0 = u.pm * BM + wr * 64 + fr, c0 = u.pn * BM + wc * 32 + 8 * fq;
#pragma unroll
        for (int ai = 0; ai < 2; ++ai)
#pragma unroll
            for (int m = 0; m < 4; ++m) { const size_t ro = (size_t)(row0 + ai * HALF + m * 16) * 1024 + c0;
#pragma unroll
                for (int bj = 0; bj < 2; ++bj) { const u32x4 y = *(const u32x4*)(YS + ro + bj * HALF); f32x4 v0 = acc[ai][bj][m][0], v1 = acc[ai][bj][m][1];
                    v0[0] = bflo(y.x) * sigm(v0[0]); v0[1] = bfhi(y.x) * sigm(v0[1]); v0[2] = bflo(y.y) * sigm(v0[2]); v0[3] = bfhi(y.y) * sigm(v0[3]);
                    v1[0] = bflo(y.z) * sigm(v1[0]); v1[1] = bfhi(y.z) * sigm(v1[1]); v1[2] = bflo(y.w) * sigm(v1[2]); v1[3] = bfhi(y.w) * sigm(v1[3]);
                    *(u32x4*)(O + ro + bj * HALF) = pack8(v0, v1); } }
    }
};
template <bool FIRST> struct EpiMerge {
    static constexpr bool PERM = true, AFTER_DRAIN = false;
    const bf16_t* G; bf16_t* O;
    __device__ __forceinline__ void operator()(const f32x4 (&acc)[2][2][4][2], const Unit& u, int wr, int wc, int fr, int fq) const {
        const int row0 = u.pm * BM + wr * 64 + fr, c0 = u.pn * BM + wc * 32 + 8 * fq;
#pragma unroll
        for (int ai = 0; ai < 2; ++ai)
#pragma unroll
            for (int m = 0; m < 4; ++m) { const int row = row0 + ai * HALF + m * 16;
#pragma unroll
                for (int bj = 0; bj < 2; ++bj) { const u32x4 g = *(const u32x4*)(G + (size_t)row * 4096 + (FIRST ? 0 : 2048) + c0 + bj * HALF); f32x4 v0 = acc[ai][bj][m][0], v1 = acc[ai][bj][m][1];
                    bf16_t* op = O + (size_t)row * 2048 + c0 + bj * HALF;
                    v0[0] *= bflo(g.x); v0[1] *= bfhi(g.x); v0[2] *= bflo(g.y); v0[3] *= bfhi(g.y); v1[0] *= bflo(g.z); v1[1] *= bfhi(g.z); v1[2] *= bflo(g.w); v1[3] *= bfhi(g.w);
                    if (!FIRST) { const u32x4 o = *(const u32x4*)op;
                        v0[0] += bflo(o.x); v0[1] += bfhi(o.x); v0[2] += bflo(o.y); v0[3] += bfhi(o.y); v1[0] += bflo(o.z); v1[1] += bfhi(o.z); v1[2] += bflo(o.w); v1[3] += bfhi(o.w); }
                    *(u32x4*)op = pack8(v0, v1); } }
    }
};
struct EpiOutRes {
    static constexpr bool PERM = false, AFTER_DRAIN = false;
    const float* R; float* C;
    __device__ __forceinline__ void operator()(const f32x4 (&acc)[2][2][4][2], const Unit& u, int wr, int wc, int fr, int fq) const {
        const int row0 = u.pm * BM + wr * 64 + fr, col0 = u.pn * BM + wc * 32 + 4 * fq;
#pragma unroll
        for (int ai = 0; ai < 2; ++ai)
#pragma unroll
            for (int m = 0; m < 4; ++m) { const size_t ro = (size_t)(row0 + ai * HALF + m * 16) * 2048 + col0;
#pragma unroll
                for (int bj = 0; bj < 2; ++bj)
#pragma unroll
                    for (int n = 0; n < 2; ++n) *(f32x4*)(C + ro + bj * HALF + n * 16) = acc[ai][bj][m][n] + *(const f32x4*)(R + ro + bj * HALF + n * 16); }
    }
};
struct EpiMoe1 {
    static constexpr bool PERM = true, AFTER_DRAIN = false;
    bf16_t* H;
    __device__ __forceinline__ void operator()(const f32x4 (&acc)[2][2][4][2], const Unit& u, int wr, int wc, int fr, int fq) const {
        const int row0 = u.pm * BM + wr * 64 + fr, c0 = u.pn * HALF + wc * 32 + 8 * fq;
#pragma unroll
        for (int ai = 0; ai < 2; ++ai)
#pragma unroll
            for (int m = 0; m < 4; ++m) { f32x4 v[2];
#pragma unroll
                for (int n = 0; n < 2; ++n)
#pragma unroll
                    for (int j = 0; j < 4; ++j) { const float g = acc[ai][0][m][n][j]; v[n][j] = g * sigm(g) * acc[ai][1][m][n][j]; }
                *(u32x4*)(H + (size_t)(row0 + ai * HALF + m * 16) * 1024 + c0) = pack8(v[0], v[1]); }
    }
};
struct EpiMoe2 {
    static constexpr bool PERM = true, AFTER_DRAIN = false;
    bf16_t* Y; const float* gw;
    __device__ __forceinline__ void operator()(const f32x4 (&acc)[2][2][4][2], const Unit& u, int wr, int wc, int fr, int fq) const {
        const int row0 = u.pm * BM + wr * 64 + fr, c0 = u.pn * BM + wc * 32 + 8 * fq;
#pragma unroll
        for (int ai = 0; ai < 2; ++ai)
#pragma unroll
            for (int m = 0; m < 4; ++m) { const int row = row0 + ai * HALF + m * 16; const float s = gw[row];
#pragma unroll
                for (int bj = 0; bj < 2; ++bj) *(u32x4*)(Y + (size_t)row * 2048 + c0 + bj * HALF) = pack8(acc[ai][bj][m][0] * s, acc[ai][bj][m][1] * s); }
    }
};

__device__ __forceinline__ float clamp448(float v) { return __builtin_fminf(__builtin_fmaxf(v, -448.f), 448.f); }
__device__ __forceinline__ unsigned pack4_fp8(float a, float b, float c, float d) { int w = 0; w = __builtin_amdgcn_cvt_pk_fp8_f32(clamp448(a), clamp448(b), w, false); w = __builtin_amdgcn_cvt_pk_fp8_f32(clamp448(c), clamp448(d), w, true); return (unsigned)w; }
constexpr float F8_WSCALE = 64.f, F8_HSCALE = 4.f;
struct EpiGateF8 {
    static constexpr bool PERM = true, AFTER_DRAIN = false;
    bf16_t* G; const float* gate_b;
    __device__ __forceinline__ void operator()(const f32x4 (&acc)[2][2][4][2], const Unit& u, int wr, int wc, int fr, int fq) const {
        const int row0 = u.pm * BM + wr * 64 + fr, c0 = u.pn * BM + wc * 32 + 8 * fq;
        f32x4 bv[2][2];
#pragma unroll
        for (int bj = 0; bj < 2; ++bj)
#pragma unroll
            for (int n = 0; n < 2; ++n) bv[bj][n] = *(const f32x4*)(gate_b + c0 + bj * HALF + 4 * n);
#pragma unroll
        for (int ai = 0; ai < 2; ++ai)
#pragma unroll
            for (int m = 0; m < 4; ++m) { bf16_t* rowp = G + (size_t)(row0 + ai * HALF + m * 16) * 4096 + c0;
#pragma unroll
                for (int bj = 0; bj < 2; ++bj) { f32x4 v0 = acc[ai][bj][m][0] * (1.f / F8_WSCALE) + bv[bj][0], v1 = acc[ai][bj][m][1] * (1.f / F8_WSCALE) + bv[bj][1];
#pragma unroll
                    for (int j = 0; j < 4; ++j) { v0[j] = sigm(v0[j]); v1[j] = sigm(v1[j]); }
                    *(u32x4*)(rowp + bj * HALF) = pack8(v0, v1); } }
    }
};
struct EpiMoe1F8 {
    static constexpr bool PERM = true, AFTER_DRAIN = false;
    unsigned char* H;
    __device__ __forceinline__ void operator()(const f32x4 (&acc)[2][2][4][2], const Unit& u, int wr, int wc, int fr, int fq) const {
        const int row0 = u.pm * BM + wr * 64 + fr, c0 = u.pn * HALF + wc * 32 + 8 * fq;
#pragma unroll
        for (int ai = 0; ai < 2; ++ai)
#pragma unroll
            for (int m = 0; m < 4; ++m) { f32x4 v[2];
#pragma unroll
                for (int n = 0; n < 2; ++n)
#pragma unroll
                    for (int j = 0; j < 4; ++j) { const float g = acc[ai][0][m][n][j] * (1.f / F8_WSCALE); v[n][j] = g * sigm(g) * acc[ai][1][m][n][j] * (F8_HSCALE / F8_WSCALE); }
                typedef unsigned u32x2_ __attribute__((ext_vector_type(2)));
                u32x2_ w; w.x = pack4_fp8(v[0][0], v[0][1], v[0][2], v[0][3]); w.y = pack4_fp8(v[1][0], v[1][1], v[1][2], v[1][3]);
                *(u32x2_*)(H + (size_t)(row0 + ai * HALF + m * 16) * 1024 + c0) = w; }
    }
};
struct EpiMoe2F8 {
    static constexpr bool PERM = true, AFTER_DRAIN = false;
    bf16_t* Y; const float* gw;
    __device__ __forceinline__ void operator()(const f32x4 (&acc)[2][2][4][2], const Unit& u, int wr, int wc, int fr, int fq) const {
        const int row0 = u.pm * BM + wr * 64 + fr, c0 = u.pn * BM + wc * 32 + 8 * fq;
#pragma unroll
        for (int ai = 0; ai < 2; ++ai)
#pragma unroll
            for (int m = 0; m < 4; ++m) { const int row = row0 + ai * HALF + m * 16; const float s = gw[row] * (1.f / (F8_WSCALE * F8_HSCALE));
#pragma unroll
                for (int bj = 0; bj < 2; ++bj) *(u32x4*)(Y + (size_t)row * 2048 + c0 + bj * HALF) = pack8(acc[ai][bj][m][0] * s, acc[ai][bj][m][1] * s); }
    }
};
struct GroupedOrder {
    int nN, G, v, total;
    __host__ __device__ void init(int nN_, int G_, int v_) { nN = nN_; G = G_; v = v_; total = 16 * 4 * nN_; }
    __host__ __device__ bool next(int i, Unit& u) const {
        const int id = i * G + v; if (id >= total) return false;
        const int per = 4 * nN, e = id / per, r = id % per; u.pm = e * 4 + (r & 3); u.pn = r >> 2; u.pb = e * nN + u.pn; return true;
    }
    __device__ __forceinline__ void a_ready(const Unit&) const {}
    __device__ __forceinline__ void done(const Unit&) const {}
};

typedef int i32x8 __attribute__((ext_vector_type(8)));
typedef int i32x4 __attribute__((ext_vector_type(4)));
__device__ __forceinline__ i32x8 cat8(bf16x8 lo, bf16x8 hi) { const i32x4 a = __builtin_bit_cast(i32x4, lo), b = __builtin_bit_cast(i32x4, hi); return __builtin_shufflevector(a, b, 0, 1, 2, 3, 4, 5, 6, 7); }
template <class Epi, class Sched, bool ALIGN_EPI = false, bool SP2 = false, bool FP8 = false>
__device__ __forceinline__ void gemm_phase(PG8_LAS unsigned char* lds, const Gemm g, const Sched& S, const Epi& E, const int wave) {
    int lane_ = lane_id_asm();
    const int wid = wave, lane = lane_, tid = wid * 64 + lane, wr = wid >> 2, wc = wid & 3, fr = lane & 15, fq = lane >> 4;
    const int K = g.K, nt = K / BK;
    unsigned voffA[2], voffB[2];
#pragma unroll
    for (int i = 0; i < 2; ++i) { int R, C; stage_rc(tid * 16 + i * 8192, R, C); const int Rb = Epi::PERM ? ((R & ~31) + perm32(R & 31)) : R;
        voffA[i] = (unsigned)(R * K + C) * 2u; voffB[i] = (unsigned)(Rb * K + C) * 2u; }
    const size_t kstep = (size_t)(BK * 2);
    const size_t hstep = (size_t)HALF * K * 2;
    const size_t tstep = 2 * hstep;
    const unsigned ldsw = (unsigned)wid * 1024u;
    const int aoff = lds_byte(wr * 64 + fr, fq * 8), boff = lds_byte(wc * 32 + fr, fq * 8);
#define PG8_SA(b, h) (((b) * 2 + (h)) * HTB)
#define PG8_SB(b, h) ((4 + (b) * 2 + (h)) * HTB)
#define PG8_STAGE(bufoff, gbase, voff) do { _Pragma("unroll") for (int _i = 0; _i < 2; ++_i) { unsigned vo_ = (voff)[_i]; if constexpr (FP8) asm volatile("" : "+v"(vo_));     \
        __builtin_amdgcn_global_load_lds((const unsigned*)((const char*)(gbase) + vo_), (PG8_LAS unsigned*)(lds + (bufoff) + ldsw + _i * 8192), 16, 0, 0); } } while (0)
#define PG8_LDA(dst, b, h) do { if constexpr (FP8) { _Pragma("unroll") for (int m = 0; m < 4; ++m) dst##8[m] = cat8(*(const PG8_LAS bf16x8*)(lds + PG8_SA(b, h) + aoff + m * 2048), *(const PG8_LAS bf16x8*)(lds + PG8_SA(b, h) + aoff + m * 2048 + 1024)); } else { \
        _Pragma("unroll") for (int m = 0; m < 4; ++m) _Pragma("unroll") for (int k = 0; k < 2; ++k) dst[m][k] = *(const PG8_LAS bf16x8*)(lds + PG8_SA(b, h) + aoff + m * 2048 + k * 1024); } } while (0)
#define PG8_LDB(dst, b, h) do { if constexpr (FP8) { _Pragma("unroll") for (int n = 0; n < 2; ++n) dst##8[n] = cat8(*(const PG8_LAS bf16x8*)(lds + PG8_SB(b, h) + boff + n * 2048), *(const PG8_LAS bf16x8*)(lds + PG8_SB(b, h) + boff + n * 2048 + 1024)); } else { \
        _Pragma("unroll") for (int n = 0; n < 2; ++n) _Pragma("unroll") for (int k = 0; k < 2; ++k) dst[n][k] = *(const PG8_LAS bf16x8*)(lds + PG8_SB(b, h) + boff + n * 2048 + k * 1024); } } while (0)
#define PG8_MMA(ai, bj, At, Bt) do { __builtin_amdgcn_s_setprio(1); if constexpr (FP8) { _Pragma("unroll") for (int m = 0; m < 4; ++m) _Pragma("unroll") for (int n = 0; n < 2; ++n) \
        acc[ai][bj][m][n] = __builtin_amdgcn_mfma_scale_f32_16x16x128_f8f6f4(Bt##8[n], At##8[m], acc[ai][bj][m][n], 0, 0, 0, 0, 0, 0); } else { \
        _Pragma("unroll") for (int m = 0; m < 4; ++m) _Pragma("unroll") for (int n = 0; n < 2; ++n) _Pragma("unroll") for (int k = 0; k < 2; ++k) \
        acc[ai][bj][m][n] = __builtin_amdgcn_mfma_f32_16x16x32_bf16(Bt[n][k], At[m][k], acc[ai][bj][m][n], 0, 0, 0); } __builtin_amdgcn_s_setprio(0); } while (0)
#define PG8_WAIT_V(n) asm volatile("s_waitcnt vmcnt(" #n ")" ::: "memory")
#define PG8_WAIT_L(n) asm volatile("s_waitcnt lgkmcnt(" #n ")" ::: "memory")
#define PG8_BAR __builtin_amdgcn_s_barrier()
#define PG8_SCHED __builtin_amdgcn_sched_barrier(0)
    Unit cur, nxt; int ui = 0;
    if (!S.next(0, cur)) return;
    f32x4 acc[2][2][4][2];
#pragma unroll
    for (int a = 0; a < 2; ++a)
#pragma unroll
        for (int b = 0; b < 2; ++b)
#pragma unroll
            for (int m = 0; m < 4; ++m)
#pragma unroll
                for (int n = 0; n < 2; ++n) acc[a][b][m][n] = (f32x4){0.f, 0.f, 0.f, 0.f};
    bf16x8 At[4][2], B0[2][2], B1[2][2]; i32x8 At8[4], B08[2], B18[2];
    const char* cA = (const char*)g.A + (size_t)cur.pm * tstep; const char* cB = (const char*)g.Bt + (size_t)cur.pb * tstep;
    S.a_ready(cur);
    if constexpr (SP2) {
        PG8_STAGE(PG8_SB(0, 0), cB, voffB); PG8_STAGE(PG8_SB(0, 1), cB + hstep, voffB); PG8_STAGE(PG8_SA(0, 0), cA, voffA); PG8_STAGE(PG8_SA(0, 1), cA + hstep, voffA);
        if (wr == 1) PG8_BAR;
        PG8_WAIT_V(2); PG8_BAR;
        PG8_STAGE(PG8_SB(1, 0), cB + kstep, voffB); PG8_STAGE(PG8_SA(1, 0), cA + kstep, voffA); PG8_STAGE(PG8_SB(1, 1), cB + hstep + kstep, voffB);
        PG8_WAIT_V(6); PG8_BAR;
    } else {
        PG8_STAGE(PG8_SB(0, 0), cB, voffB); PG8_STAGE(PG8_SA(0, 0), cA, voffA); PG8_STAGE(PG8_SB(0, 1), cB + hstep, voffB); PG8_STAGE(PG8_SA(0, 1), cA + hstep, voffA);
        if (wr == 1) PG8_BAR;
        PG8_WAIT_V(4); PG8_BAR;
        PG8_STAGE(PG8_SB(1, 0), cB + kstep, voffB); PG8_STAGE(PG8_SA(1, 0), cA + kstep, voffA); PG8_STAGE(PG8_SB(1, 1), cB + hstep + kstep, voffB);
        PG8_WAIT_V(6); PG8_BAR;
    }
    for (;;) {
        const bool has_next = S.next(ui + 1, nxt);
        const char* nA = has_next ? (const char*)g.A + (size_t)nxt.pm * tstep : cA; const char* nB = has_next ? (const char*)g.Bt + (size_t)nxt.pb * tstep : cB;
#pragma nounroll
        for (int t = 0; t < nt; t += 2) {
            const bool last = (t == nt - 2);
            const char* a1 = cA + (size_t)(t + 1) * kstep;
            const char* a2 = last ? nA : cA + (size_t)(t + 2) * kstep; const char* b2 = last ? nB : cB + (size_t)(t + 2) * kstep;
            const char* a3 = a2 + kstep; const char* b3 = b2 + kstep;
            if (last && has_next) S.a_ready(nxt);
            if constexpr (SP2) {
            PG8_LDB(B0, 0, 0); PG8_LDB(B1, 0, 1); PG8_SCHED; PG8_LDA(At, 0, 0); PG8_STAGE(PG8_SA(1, 1), a1 + hstep, voffA);
            PG8_WAIT_V(8); PG8_WAIT_L(0); PG8_BAR; PG8_MMA(0, 0, At, B0); PG8_MMA(0, 1, At, B1); PG8_BAR; PG8_SCHED;
            PG8_LDA(At, 0, 1); PG8_STAGE(PG8_SB(0, 0), b2, voffB); PG8_STAGE(PG8_SB(0, 1), b2 + hstep, voffB); PG8_STAGE(PG8_SA(0, 0), a2, voffA);
            PG8_WAIT_V(8); PG8_WAIT_L(0); PG8_BAR; PG8_MMA(1, 0, At, B0); PG8_MMA(1, 1, At, B1); PG8_BAR; PG8_SCHED;
            PG8_LDB(B0, 1, 0); PG8_LDB(B1, 1, 1); PG8_SCHED; PG8_LDA(At, 1, 0); PG8_STAGE(PG8_SA(0, 1), a2 + hstep, voffA);
            PG8_WAIT_V(8); PG8_WAIT_L(0); PG8_BAR; PG8_MMA(0, 0, At, B0); PG8_MMA(0, 1, At, B1); PG8_BAR; PG8_SCHED;
            PG8_LDA(At, 1, 1); PG8_STAGE(PG8_SB(1, 0), b3, voffB); PG8_STAGE(PG8_SB(1, 1), b3 + hstep, voffB); PG8_STAGE(PG8_SA(1, 0), a3, voffA);
            PG8_WAIT_V(8); PG8_WAIT_L(0); PG8_BAR; PG8_MMA(1, 0, At, B0); PG8_MMA(1, 1, At, B1); PG8_BAR; PG8_SCHED;
            } else {
            PG8_LDB(B0, 0, 0); PG8_SCHED; PG8_LDA(At, 0, 0); PG8_STAGE(PG8_SA(1, 1), a1 + hstep, voffA);
            PG8_WAIT_L(8); PG8_BAR; PG8_WAIT_L(0); PG8_MMA(0, 0, At, B0); PG8_BAR; PG8_SCHED;
            PG8_LDB(B1, 0, 1); PG8_STAGE(PG8_SB(0, 0), b2, voffB);
            PG8_BAR; PG8_WAIT_L(0); PG8_MMA(0, 1, At, B1); PG8_BAR;
            PG8_LDA(At, 0, 1); PG8_STAGE(PG8_SA(0, 0), a2, voffA);
            PG8_BAR; PG8_WAIT_L(0); PG8_MMA(1, 0, At, B0); PG8_BAR; PG8_SCHED;
            PG8_STAGE(PG8_SB(0, 1), b2 + hstep, voffB);
            PG8_WAIT_V(6); PG8_BAR; PG8_MMA(1, 1, At, B1); PG8_BAR;
            PG8_LDB(B0, 1, 0); PG8_SCHED; PG8_LDA(At, 1, 0); PG8_STAGE(PG8_SA(0, 1), a2 + hstep, voffA);
            PG8_WAIT_L(8); PG8_BAR; PG8_WAIT_L(0); PG8_MMA(0, 0, At, B0); PG8_BAR; PG8_SCHED;
            PG8_LDB(B1, 1, 1); PG8_STAGE(PG8_SB(1, 0), b3, voffB);
            PG8_BAR; PG8_WAIT_L(0); PG8_MMA(0, 1, At, B1); PG8_BAR;
            PG8_LDA(At, 1, 1); PG8_STAGE(PG8_SA(1, 0), a3, voffA);
            PG8_BAR; PG8_WAIT_L(0); PG8_MMA(1, 0, At, B0); PG8_BAR; PG8_SCHED;
            PG8_STAGE(PG8_SB(1, 1), b3 + hstep, voffB);
            PG8_WAIT_V(6); PG8_BAR; PG8_MMA(1, 1, At, B1); PG8_BAR;
            }
        }
        if constexpr (ALIGN_EPI) { if (wr == 0) PG8_BAR; }
        if constexpr (!Epi::AFTER_DRAIN) { if constexpr (FP8) { int l2_ = lane_id_asm(); E(acc, cur, wr, wc, l2_ & 15, l2_ >> 4); }
            else E(acc, cur, wr, wc, fr, fq); S.done(cur); }
        if (!has_next) break;
#pragma unroll
        for (int a = 0; a < 2; ++a)
#pragma unroll
            for (int b = 0; b < 2; ++b)
#pragma unroll
                for (int m = 0; m < 4; ++m)
#pragma unroll
                    for (int n = 0; n < 2; ++n) acc[a][b][m][n] = (f32x4){0.f, 0.f, 0.f, 0.f};
        cur = nxt; cA = nA; cB = nB; ++ui;
        if constexpr (ALIGN_EPI) { if (wr == 1) PG8_BAR; }
    }
    PG8_WAIT_V(0);
    if constexpr (!ALIGN_EPI) { if (wr == 0) PG8_BAR; }
    PG8_BAR;
    if constexpr (Epi::AFTER_DRAIN) { E.fused(acc, cur, wr, wc, fr, fq, lds, wid, lane); S.done(cur); }
#undef PG8_SA
#undef PG8_SB
#undef PG8_STAGE
#undef PG8_LDA
#undef PG8_LDB
#undef PG8_MMA
#undef PG8_WAIT_V
#undef PG8_WAIT_L
#undef PG8_BAR
#undef PG8_SCHED
}
template <class Epi, class Sched, bool FP8 = false>
__device__ __forceinline__ void gemm_phase_gather(PG8_LAS unsigned char* lds, const Gemm g, const Sched& S, const Epi& E, const int wave, const int* rowidx) {
    constexpr bool ALIGN_EPI = true, SP2 = true;
    int lane_ = lane_id_asm();
    const int wid = wave, lane = lane_, tid = wid * 64 + lane, wr = wid >> 2, wc = wid & 3, fr = lane & 15, fq = lane >> 4;
    const int K = g.K, nt = K / BK;
    unsigned voffB[2];
#pragma unroll
    for (int i = 0; i < 2; ++i) { int R, C; stage_rc(tid * 16 + i * 8192, R, C); const int Rb = Epi::PERM ? ((R & ~31) + perm32(R & 31)) : R;
        voffB[i] = (unsigned)(Rb * K + C) * 2u; }
    unsigned oC[2][2], oN[2][2];
#define PG8_GOFF(dst, u) do { _Pragma("unroll") for (int i_ = 0; i_ < 2; ++i_) { int R_, C_; stage_rc(tid * 16 + i_ * 8192, R_, C_); _Pragma("unroll") for (int h_ = 0; h_ < 2; ++h_) dst[h_][i_] = (unsigned)rowidx[(u).pm * BM + h_ * HALF + R_] * (unsigned)(K * 2) + (unsigned)(C_ * 2); } } while (0)
    const size_t kstep = (size_t)(BK * 2);
    const size_t hstep = (size_t)HALF * K * 2;
    const size_t tstep = 2 * hstep;
    const unsigned ldsw = (unsigned)wid * 1024u;
    const int aoff = lds_byte(wr * 64 + fr, fq * 8), boff = lds_byte(wc * 32 + fr, fq * 8);
#define PG8_SA(b, h) (((b) * 2 + (h)) * HTB)
#define PG8_SB(b, h) ((4 + (b) * 2 + (h)) * HTB)
#define PG8_STAGE(bufoff, gbase, voff) do { _Pragma("unroll") for (int _i = 0; _i < 2; ++_i) { unsigned vo_ = (voff)[_i]; if constexpr (FP8) asm volatile("" : "+v"(vo_));     \
        __builtin_amdgcn_global_load_lds((const unsigned*)((const char*)(gbase) + vo_), (PG8_LAS unsigned*)(lds + (bufoff) + ldsw + _i * 8192), 16, 0, 0); } } while (0)
#define PG8_LDA(dst, b, h) do { if constexpr (FP8) { _Pragma("unroll") for (int m = 0; m < 4; ++m) dst##8[m] = cat8(*(const PG8_LAS bf16x8*)(lds + PG8_SA(b, h) + aoff + m * 2048), *(const PG8_LAS bf16x8*)(lds + PG8_SA(b, h) + aoff + m * 2048 + 1024)); } else { \
        _Pragma("unroll") for (int m = 0; m < 4; ++m) _Pragma("unroll") for (int k = 0; k < 2; ++k) dst[m][k] = *(const PG8_LAS bf16x8*)(lds + PG8_SA(b, h) + aoff + m * 2048 + k * 1024); } } while (0)
#define PG8_LDB(dst, b, h) do { if constexpr (FP8) { _Pragma("unroll") for (int n = 0; n < 2; ++n) dst##8[n] = cat8(*(const PG8_LAS bf16x8*)(lds + PG8_SB(b, h) + boff + n * 2048), *(const PG8_LAS bf16x8*)(lds + PG8_SB(b, h) + boff + n * 2048 + 1024)); } else { \
        _Pragma("unroll") for (int n = 0; n < 2; ++n) _Pragma("unroll") for (int k = 0; k < 2; ++k) dst[n][k] = *(const PG8_LAS bf16x8*)(lds + PG8_SB(b, h) + boff + n * 2048 + k * 1024); } } while (0)
#define PG8_MMA(ai, bj, At, Bt) do { __builtin_amdgcn_s_setprio(1); if constexpr (FP8) { _Pragma("unroll") for (int m = 0; m < 4; ++m) _Pragma("unroll") for (int n = 0; n < 2; ++n) \
        acc[ai][bj][m][n] = __builtin_amdgcn_mfma_scale_f32_16x16x128_f8f6f4(Bt##8[n], At##8[m], acc[ai][bj][m][n], 0, 0, 0, 0, 0, 0); } else { \
        _Pragma("unroll") for (int m = 0; m < 4; ++m) _Pragma("unroll") for (int n = 0; n < 2; ++n) _Pragma("unroll") for (int k = 0; k < 2; ++k) \
        acc[ai][bj][m][n] = __builtin_amdgcn_mfma_f32_16x16x32_bf16(Bt[n][k], At[m][k], acc[ai][bj][m][n], 0, 0, 0); } __builtin_amdgcn_s_setprio(0); } while (0)
#define PG8_WAIT_V(n) asm volatile("s_waitcnt vmcnt(" #n ")" ::: "memory")
#define PG8_WAIT_L(n) asm volatile("s_waitcnt lgkmcnt(" #n ")" ::: "memory")
#define PG8_BAR __builtin_amdgcn_s_barrier()
#define PG8_SCHED __builtin_amdgcn_sched_barrier(0)
    Unit cur, nxt; int ui = 0;
    if (!S.next(0, cur)) return;
    f32x4 acc[2][2][4][2];
#pragma unroll
    for (int a = 0; a < 2; ++a)
#pragma unroll
        for (int b = 0; b < 2; ++b)
#pragma unroll
            for (int m = 0; m < 4; ++m)
#pragma unroll
                for (int n = 0; n < 2; ++n) acc[a][b][m][n] = (f32x4){0.f, 0.f, 0.f, 0.f};
    bf16x8 At[4][2], B0[2][2], B1[2][2]; i32x8 At8[4], B08[2], B18[2];
    const char* const gA = (const char*)g.A; const char* cB = (const char*)g.Bt + (size_t)cur.pb * tstep;
    S.a_ready(cur);
    PG8_GOFF(oC, cur);
    {
        PG8_STAGE(PG8_SB(0, 0), cB, voffB); PG8_STAGE(PG8_SB(0, 1), cB + hstep, voffB); PG8_STAGE(PG8_SA(0, 0), gA, oC[0]); PG8_STAGE(PG8_SA(0, 1), gA, oC[1]);
        if (wr == 1) PG8_BAR;
        PG8_WAIT_V(2); PG8_BAR;
        PG8_STAGE(PG8_SB(1, 0), cB + kstep, voffB); PG8_STAGE(PG8_SA(1, 0), gA + kstep, oC[0]); PG8_STAGE(PG8_SB(1, 1), cB + hstep + kstep, voffB);
        PG8_WAIT_V(6); PG8_BAR;
    }
    for (;;) {
        const bool has_next = S.next(ui + 1, nxt);
        const char* nB = has_next ? (const char*)g.Bt + (size_t)nxt.pb * tstep : cB;
        if (has_next) PG8_GOFF(oN, nxt); else { _Pragma("unroll") for (int h_ = 0; h_ < 2; ++h_) _Pragma("unroll") for (int i_ = 0; i_ < 2; ++i_) oN[h_][i_] = oC[h_][i_]; }
#pragma nounroll
        for (int t = 0; t < nt; t += 2) {
            const bool last = (t == nt - 2);
            const char* a1 = gA + (size_t)(t + 1) * kstep;
            const char* a2 = last ? gA : gA + (size_t)(t + 2) * kstep; const char* b2 = last ? nB : cB + (size_t)(t + 2) * kstep;
            const char* a3 = a2 + kstep; const char* b3 = b2 + kstep;
            unsigned o2[2][2];
            _Pragma("unroll") for (int h_ = 0; h_ < 2; ++h_) _Pragma("unroll") for (int i_ = 0; i_ < 2; ++i_) o2[h_][i_] = last ? oN[h_][i_] : oC[h_][i_];
            if (last && has_next) S.a_ready(nxt);
            {
            PG8_LDB(B0, 0, 0); PG8_LDB(B1, 0, 1); PG8_SCHED; PG8_LDA(At, 0, 0); PG8_STAGE(PG8_SA(1, 1), a1, oC[1]);
            PG8_WAIT_V(8); PG8_WAIT_L(0); PG8_BAR; PG8_MMA(0, 0, At, B0); PG8_MMA(0, 1, At, B1); PG8_BAR; PG8_SCHED;
            PG8_LDA(At, 0, 1); PG8_STAGE(PG8_SB(0, 0), b2, voffB); PG8_STAGE(PG8_SB(0, 1), b2 + hstep, voffB); PG8_STAGE(PG8_SA(0, 0), a2, o2[0]);
            PG8_WAIT_V(8); PG8_WAIT_L(0); PG8_BAR; PG8_MMA(1, 0, At, B0); PG8_MMA(1, 1, At, B1); PG8_BAR; PG8_SCHED;
            PG8_LDB(B0, 1, 0); PG8_LDB(B1, 1, 1); PG8_SCHED; PG8_LDA(At, 1, 0); PG8_STAGE(PG8_SA(0, 1), a2, o2[1]);
            PG8_WAIT_V(8); PG8_WAIT_L(0); PG8_BAR; PG8_MMA(0, 0, At, B0); PG8_MMA(0, 1, At, B1); PG8_BAR; PG8_SCHED;
            PG8_LDA(At, 1, 1); PG8_STAGE(PG8_SB(1, 0), b3, voffB); PG8_STAGE(PG8_SB(1, 1), b3 + hstep, voffB); PG8_STAGE(PG8_SA(1, 0), a3, o2[0]);
            PG8_WAIT_V(8); PG8_WAIT_L(0); PG8_BAR; PG8_MMA(1, 0, At, B0); PG8_MMA(1, 1, At, B1); PG8_BAR; PG8_SCHED;
            }
        }
        if constexpr (ALIGN_EPI) { if (wr == 0) PG8_BAR; }
        if constexpr (!Epi::AFTER_DRAIN) { if constexpr (FP8) { int l2_ = lane_id_asm(); E(acc, cur, wr, wc, l2_ & 15, l2_ >> 4); }
            else E(acc, cur, wr, wc, fr, fq); S.done(cur); }
        if (!has_next) break;
#pragma unroll
        for (int a = 0; a < 2; ++a)
#pragma unroll
            for (int b = 0; b < 2; ++b)
#pragma unroll
                for (int m = 0; m < 4; ++m)
#pragma unroll
                    for (int n = 0; n < 2; ++n) acc[a][b][m][n] = (f32x4){0.f, 0.f, 0.f, 0.f};
        cur = nxt; cB = nB; ++ui;
        _Pragma("unroll") for (int h_ = 0; h_ < 2; ++h_) _Pragma("unroll") for (int i_ = 0; i_ < 2; ++i_) oC[h_][i_] = oN[h_][i_];
        if constexpr (ALIGN_EPI) { if (wr == 1) PG8_BAR; }
    }
    PG8_WAIT_V(0);
    if constexpr (!ALIGN_EPI) { if (wr == 0) PG8_BAR; }
    PG8_BAR;
    if constexpr (Epi::AFTER_DRAIN) { E.fused(acc, cur, wr, wc, fr, fq, lds, wid, lane); S.done(cur); }
#undef PG8_GOFF
#undef PG8_SA
#undef PG8_SB
#undef PG8_STAGE
#undef PG8_LDA
#undef PG8_LDB
#undef PG8_MMA
#undef PG8_WAIT_V
#undef PG8_WAIT_L
#undef PG8_BAR
#undef PG8_SCHED
}
}

#ifndef PG8_SP2
#define PG8_SP2 true
#endif
#ifndef PG8_ALIGN
#define PG8_ALIGN true
#endif

constexpr int SEQ = 8192, DM = 2048, DEPTH = 2;
constexpr int DSSM = 1024, NG = 64, SG = 16, SP = 64;
constexpr int DATT = 1024, NHEAD = 8, HD = 64, NHH = 16;
constexpr int INC = 8192;
constexpr int NE = 16, DE = 1024, CAP = 1024;
constexpr float EPS = 1e-6f;
constexpr float QSCALE = 0.125f * 1.4426950408889634f;
constexpr int NWAVES = 8;

constexpr size_t MiB = 1u << 20;
constexpr size_t WS_CTL = 0, CTL_ZERO_BYTES = 1 * MiB;
constexpr size_t WS_SCAL = 1 * MiB;
constexpr size_t WS_ROPEC = 2 * MiB, WS_ROPES = 2 * MiB + 256 * 1024;
constexpr size_t WS_QNRM = 3 * MiB;
constexpr size_t WS_EMAT = 4 * MiB;
constexpr size_t WS_WMAT = 20 * MiB;
constexpr size_t WS_LAMB = 52 * MiB;
constexpr size_t WS_WRT = 53 * MiB;
constexpr size_t WS_BBAR = 53 * MiB;
constexpr size_t WS_WIN = 56 * MiB;
constexpr size_t WIN8_OFF = 16 * MiB;
constexpr size_t WS_H8 = 910 * MiB;
constexpr size_t WS_WGLU = 120 * MiB;
constexpr size_t WS_WBS = 124 * MiB;
constexpr size_t WS_WBA = 132 * MiB;
constexpr size_t WS_WOUT = 140 * MiB;
constexpr size_t WS_WGU = 156 * MiB;
constexpr size_t WS_WD = 412 * MiB;
constexpr size_t WS_XB = 540 * MiB;
constexpr size_t WS_HN = 604 * MiB;
constexpr size_t WS_U = 636 * MiB, WS_QRAW = 652 * MiB, WS_KRAW = 668 * MiB, WS_V = 684 * MiB;
static_assert(WS_KRAW == WS_QRAW + 16 * MiB && WS_V == WS_QRAW + 32 * MiB, "EpiInProj addresses q | k | v from the q base");
constexpr size_t WS_GATE = 700 * MiB;
constexpr size_t WS_QN = 764 * MiB, WS_KN = 780 * MiB;
constexpr size_t WS_YS = 796 * MiB, WS_YS2 = 812 * MiB, WS_YA = 828 * MiB;
constexpr size_t WS_MERGED = 844 * MiB;
constexpr size_t WS_AFF = 876 * MiB;
constexpr size_t WS_SEL = 876 * MiB + 512 * 1024;
constexpr size_t WS_IDX = 877 * MiB;
constexpr size_t WS_GW = 877 * MiB + 64 * 1024;
constexpr size_t WS_SSME = 878 * MiB;
constexpr size_t WS_ATMP = 910 * MiB;
constexpr size_t WS_NAO = 942 * MiB;
constexpr size_t WS_HE = WS_QRAW;
constexpr size_t WS_XE = WS_GATE;
constexpr size_t WS_YE = WS_GATE;
constexpr size_t WS_END = 1006 * MiB;
constexpr int CW_TMO = 0, CW_CODE = 1;
constexpr int CW_ITEM = 1024;
constexpr int CW_KMAX = 64;
constexpr int CW_BAR = 4096;

constexpr int RING_OFF = 0, RING_BYTES = 139264;
constexpr int LDSCTL_OFF = RING_BYTES, MISC_OFF = LDSCTL_OFF + 320;
constexpr int LDS_BYTES = 147456;

#define GAS __attribute__((address_space(1)))
#define LAS __attribute__((address_space(3)))
typedef unsigned short bf16;
typedef unsigned v4u __attribute__((ext_vector_type(4)));
typedef unsigned v2u __attribute__((ext_vector_type(2)));
typedef float f32x4 __attribute__((ext_vector_type(4)));
typedef GAS unsigned gu32;
#define RLX_AGENT __ATOMIC_RELAXED, __HIP_MEMORY_SCOPE_AGENT
#define LDS_WAIT() asm volatile("s_waitcnt lgkmcnt(0)" ::: "memory")
#define VM_WAIT() asm volatile("s_waitcnt vmcnt(0)" ::: "memory")
__device__ __forceinline__ unsigned f2bf(float f) { unsigned u = __builtin_bit_cast(unsigned, f); return (u + 0x7fffu + ((u >> 16) & 1u)) >> 16; }
__device__ __forceinline__ unsigned pk2(float lo, float hi) { return f2bf(lo) | (f2bf(hi) << 16); }
__device__ __forceinline__ float bflo(unsigned w) { return __uint_as_float(w << 16); }
__device__ __forceinline__ float bfhi(unsigned w) { return __uint_as_float(w & 0xffff0000u); }
__device__ __forceinline__ float bf2f(bf16 b) { return __uint_as_float(((unsigned)b) << 16); }

#define XB_TMO      128
#define XB_XCNT(j)  (256  + 64 * (j))
#define XB_XSUB(j)  (1280 + 64 * (j))
#define XB_XGEN(j)  (2304 + 64 * (j))
#define XB_TOP      3328
#define XB_TOPGEN   3392
#define XCD_BAR_WORDS 3456
#define XB_SPIN_CAP (1u << 18)

__device__ __forceinline__ unsigned xb_ld(unsigned* p)              { return __hip_atomic_load(p, __ATOMIC_RELAXED, __HIP_MEMORY_SCOPE_AGENT); }
__device__ __forceinline__ unsigned xb_add(unsigned* p, unsigned v) { return __hip_atomic_fetch_add(p, v, __ATOMIC_RELAXED, __HIP_MEMORY_SCOPE_AGENT); }
__device__ __forceinline__ unsigned xb_xcc_id() { return (unsigned)__builtin_amdgcn_s_getreg((3 << 11) | 20) & 0xFu; }
#define XB_SPIN(cond, bar) do { unsigned _sp = 0; while (cond) { __builtin_amdgcn_s_sleep(1); \
    if ((++_sp & 255u) == 0u) { if (xb_ld(&(bar)[XB_TMO])) break; if (_sp > XB_SPIN_CAP) { atomicAdd(&(bar)[XB_TMO], 1u); break; } } } } while (0)

struct XcdBarrier {
    unsigned* bar; unsigned x; unsigned w0;
    volatile LAS unsigned* st;
};

__device__ __forceinline__ bool xb_lane0() { return lane_id_asm() == 0; }
__device__ __forceinline__ XcdBarrier xcd_barrier_post(unsigned* bar, volatile LAS unsigned* st, unsigned w0) {
    XcdBarrier b; b.bar = bar; b.x = xb_xcc_id(); b.st = st; b.w0 = w0;
    if (w0 && xb_lane0()) (void)xb_add(&bar[XB_XCNT(b.x)], 1u);
    return b;
}
__device__ __forceinline__ void xcd_barrier_complete(unsigned* bar, unsigned x, unsigned& nloc, unsigned& nx) {
    const unsigned G = gridDim.x * gridDim.y * gridDim.z;
    unsigned sum, cnt, mine, sp = 0u;
    for (;;) {
        sum = 0u; cnt = 0u; mine = 0u;
#pragma unroll
        for (unsigned j = 0; j < 16; ++j) { const unsigned c = xb_ld(&bar[XB_XCNT(j)]); sum += c; cnt += (c > 0u) ? 1u : 0u; mine = (j == x) ? c : mine; }
        if (sum == G) break;
        __builtin_amdgcn_s_sleep(1);
        if ((++sp & 255u) == 0u) { if (xb_ld(&bar[XB_TMO])) break; if (sp > XB_SPIN_CAP) { atomicAdd(&bar[XB_TMO], 1u); break; } }
    }
    nloc = mine > 0u ? mine : 1u; nx = cnt > 0u ? cnt : 1u;
}

__device__ __forceinline__ void xcd_barrier(const XcdBarrier& b) {
    asm volatile("s_waitcnt vmcnt(0)" ::: "memory");
    __syncthreads();
    if (b.w0 && xb_lane0()) {
        unsigned* bar = b.bar;
        __builtin_amdgcn_s_waitcnt(0);
        unsigned nloc = b.st[0], nx = b.st[1];
        if (nloc == 0u) { xcd_barrier_complete(bar, b.x, nloc, nx); b.st[0] = nloc; b.st[1] = nx; }
        const unsigned old = xb_add(&bar[XB_XSUB(b.x)], 1u);
        const unsigned gen = old / nloc;
        if (old + 1u == (gen + 1u) * nloc) {
            __builtin_amdgcn_fence(__ATOMIC_RELEASE, "agent");
            asm volatile("s_waitcnt vmcnt(0)" ::: "memory");
            const unsigned og = xb_add(&bar[XB_TOP], 1u);
            const unsigned tg = og / nx;
            if (og + 1u == (tg + 1u) * nx) xb_add(&bar[XB_TOPGEN], 1u);
            else XB_SPIN(xb_ld(&bar[XB_TOPGEN]) == tg, bar);
            __builtin_amdgcn_fence(__ATOMIC_ACQUIRE, "agent");
            xb_add(&bar[XB_XGEN(b.x)], 1u);
            asm volatile("s_waitcnt vmcnt(0)" ::: "memory");
        } else {
            XB_SPIN(xb_ld(&bar[XB_XGEN(b.x)]) == gen, bar);
            __builtin_amdgcn_fence(__ATOMIC_ACQUIRE, "agent");
            asm volatile("s_waitcnt vmcnt(0)" ::: "memory");
        }
    }
    __syncthreads();
}

struct Args { const float* in[28]; float* out; unsigned char* ws; int ph_lo, ph_hi, bar_idx, pad; };
struct Frame {
    LAS unsigned char* lds;
    volatile LAS unsigned* MISC;
    gu32* ctl;
    GAS unsigned char* ws; GAS float* out;
    int wave, vcu, G;
};
__device__ __forceinline__ int fresh_v(int x) { asm volatile("" : "+v"(x)); return x; }
__device__ __forceinline__ int lane_fresh() { return lane_id_asm(); }
__device__ __forceinline__ int fresh_s(int x) { asm volatile("" : "+s"(x)); return x; }
__device__ __forceinline__ float bperm_f(int srclane, float v) { return __int_as_float(__builtin_amdgcn_ds_bpermute(srclane << 2, __float_as_int(v))); }
__device__ __forceinline__ int bperm_i(int srclane, int v) { return __builtin_amdgcn_ds_bpermute(srclane << 2, v); }
__device__ __forceinline__ float wave_sum(float v, int lane) {
#pragma unroll
    for (int o = 1; o < 64; o <<= 1) v += bperm_f(lane ^ o, v);
    return v;
}
__device__ __forceinline__ float lam_init_of(int l) { return 0.8f - 0.6f * expf(-0.3f * (float)l); }

struct TrItem { const float* src; unsigned char* dst; int N, K, k0; bool is8; };
__device__ __forceinline__ void tr_load(const TrItem& d, f32x4 (&v)[16]) {
    const GAS f32x4* src = (const GAS f32x4*)d.src;
#pragma unroll
    for (int i = 0; i < 16; ++i) v[i] = src[(size_t)i * d.N];
}
__device__ __forceinline__ void tr_store(const TrItem& d, const f32x4 (&v)[16], LAS unsigned char* scr8, int lane) {
    const int kq = lane >> 4, n4 = (lane & 15) * 4;
    if (d.is8) {
#pragma unroll
        for (int i = 0; i < 16; ++i) { const unsigned w = pg8::pack4_fp8(v[i].x * pg8::F8_WSCALE, v[i].y * pg8::F8_WSCALE, v[i].z * pg8::F8_WSCALE, v[i].w * pg8::F8_WSCALE);
            scr8[(n4 + 0) * 80 + 4 * i + kq] = (unsigned char)(w & 0xffu); scr8[(n4 + 1) * 80 + 4 * i + kq] = (unsigned char)((w >> 8) & 0xffu);
            scr8[(n4 + 2) * 80 + 4 * i + kq] = (unsigned char)((w >> 16) & 0xffu); scr8[(n4 + 3) * 80 + 4 * i + kq] = (unsigned char)(w >> 24); }
        LDS_WAIT(); asm volatile("" ::: "memory");
        const int c = lane & 3;
#pragma unroll
        for (int j = 0; j < 4; ++j) { const int n = (lane >> 2) + 16 * j; const v4u o = *(const LAS v4u*)(scr8 + n * 80 + 16 * c);
            *(GAS v4u*)(d.dst + (size_t)n * d.K + d.k0 + 16 * c) = o; }
    } else {
        LAS bf16* scr = (LAS bf16*)scr8;
#pragma unroll
        for (int i = 0; i < 16; ++i) { const unsigned a = pk2(v[i].x, v[i].y), b = pk2(v[i].z, v[i].w);
            scr[(n4 + 0) * 72 + 4 * i + kq] = (bf16)(a & 0xffffu); scr[(n4 + 1) * 72 + 4 * i + kq] = (bf16)(a >> 16);
            scr[(n4 + 2) * 72 + 4 * i + kq] = (bf16)(b & 0xffffu); scr[(n4 + 3) * 72 + 4 * i + kq] = (bf16)(b >> 16); }
        LDS_WAIT(); asm volatile("" ::: "memory");
        const int c = lane & 7;
#pragma unroll
        for (int j = 0; j < 8; ++j) { const int n = (lane >> 3) + 8 * j; const v4u o = *(const LAS v4u*)(scr + n * 72 + 8 * c);
            *(GAS v4u*)((bf16*)d.dst + (size_t)n * d.K + d.k0 + 8 * c) = o; }
    }
    LDS_WAIT(); asm volatile("" ::: "memory");
}
__device__ __forceinline__ void ssm_tables_unit(Frame& F, const Args& a, int l, int g);
constexpr int P0_I_PER_E = 2 * 32 * 16 + 16 * 32, P0_I_PER_L = 32 * 128 + 16 * 16 + 2 * 16 * 32 + 32 * 32 + 16 * P0_I_PER_E, P0_I_TOTAL = 2 * P0_I_PER_L;
constexpr int P0_DEF_TOPK = 5, P0_DEF_GLU = 3, P0_DEFER = (2 * P0_DEF_TOPK + 2 * P0_DEF_GLU) * P0_I_PER_E;
constexpr int P0_END_TOPK0 = 0, P0_END_GLU0 = P0_DEF_TOPK, P0_END_GLU1 = P0_DEF_TOPK + P0_DEF_GLU, P0_END_TOPK1 = P0_DEF_TOPK + 2 * P0_DEF_GLU;
template <bool DYN> __device__ __forceinline__ void convert_items(Frame& F, const Args& a, const int it0, const int it1, const int gw, const int NGW) {
    LAS unsigned char* scr = (LAS unsigned char*)(F.lds + RING_OFF + F.wave * 16384);
    const int lane_ = lane_fresh();
    constexpr int I_IN = 32 * 128, I_GLU = 16 * 16, I_BR = 16 * 32, I_OUT = 32 * 32, I_EG = 32 * 16, I_ED = 16 * 32;
    constexpr int PER_L = I_IN + I_GLU + 2 * I_BR + I_OUT + 16 * (2 * I_EG + I_ED), TOTAL = DEPTH * PER_L;
    auto decode = [&](int it, TrItem& d) {
        const int l = it / PER_L; int r = it % PER_L;
        const float* W; int K, N; unsigned char* dst; int mode = 0; bool is8 = false;
        if (r < I_IN) { W = a.in[2] + (size_t)l * DM * INC; K = DM; N = INC; dst = (unsigned char*)(F.ws + WS_WIN + (size_t)l * INC * DM * 2); mode = 3; }
        else if ((r -= I_IN) < I_GLU) { W = a.in[12] + (size_t)l * DSSM * DSSM; K = DSSM; N = DSSM; dst = (unsigned char*)(F.ws + WS_WGLU + (size_t)l * DSSM * DSSM * 2); }
        else if ((r -= I_GLU) < I_BR) { W = a.in[20] + (size_t)l * DSSM * DM; K = DSSM; N = DM; dst = (unsigned char*)(F.ws + WS_WBS + (size_t)l * DM * DSSM * 2); }
        else if ((r -= I_BR) < I_BR) { W = a.in[21] + (size_t)l * DATT * DM; K = DATT; N = DM; dst = (unsigned char*)(F.ws + WS_WBA + (size_t)l * DM * DATT * 2); }
        else if ((r -= I_BR) < I_OUT) { W = a.in[22] + (size_t)l * DM * DM; K = DM; N = DM; dst = (unsigned char*)(F.ws + WS_WOUT + (size_t)l * DM * DM * 2); }
        else { r -= I_OUT; constexpr int PER_E = 2 * I_EG + I_ED; const int e = r / PER_E; r %= PER_E; const size_t le = (size_t)l * NE + e;
            is8 = true;
            if (r < I_EG) { W = a.in[25] + le * DM * DE; K = DM; N = DE; dst = (unsigned char*)(F.ws + WS_WGU + le * 2048 * 2048); mode = 1; }
            else if ((r -= I_EG) < I_EG) { W = a.in[26] + le * DM * DE; K = DM; N = DE; dst = (unsigned char*)(F.ws + WS_WGU + le * 2048 * 2048); mode = 2; }
            else { r -= I_EG; W = a.in[27] + le * DE * DM; K = DE; N = DM; dst = (unsigned char*)(F.ws + WS_WD + le * 2048 * 1024); } }
        const int nblk = N / 64, kb = r / nblk, nb = r % nblk, n0 = 64 * nb;
        int drow = (mode == 0 || mode == 3) ? n0 : ((n0 >> 7) * 256 + (n0 & 127) + (mode == 2 ? 128 : 0));
        if (mode == 3 && n0 >= 4096) { is8 = true; dst += WIN8_OFF; drow = n0 - 4096; }
        d.src = W + (size_t)(64 * kb + (lane_ >> 4)) * N + n0 + (lane_ & 15) * 4; d.N = N; d.K = K; d.k0 = 64 * kb; d.is8 = is8;
        d.dst = dst + (size_t)drow * K * (is8 ? 1 : 2);
    };
    static_assert(PER_L == P0_I_PER_L, "item count");
    { TrItem dA, dB; f32x4 vA[16], vB[16];
      const int grp = fresh_s(F.vcu) >> 3;
      auto grab = [&]() -> int { int v = 0; if (lane_ == 0) v = (int)__hip_atomic_fetch_add((unsigned*)(F.ctl + CW_ITEM + grp * 64), 1u, RLX_AGENT); v = __builtin_amdgcn_readfirstlane(v);
          return it0 + ((v >> 3) * 32 + grp) * 8 + (v & 7); };
      int it = DYN ? grab() : it0 + gw; const int TOTAL_ = it1; bool hasA = it < TOTAL_;
      if (hasA) { decode(it, dA); tr_load(dA, vA); }
      while (hasA) {
          const int itB = DYN ? grab() : it + NGW; const bool hasB = itB < TOTAL_;
          if (hasB) { decode(itB, dB); tr_load(dB, vB); }
          tr_store(dA, vA, scr, lane_);
          if (!hasB) break;
          it = DYN ? grab() : itB + NGW; hasA = it < TOTAL_;
          if (hasA) { decode(it, dA); tr_load(dA, vA); }
          tr_store(dB, vB, scr, lane_);
      } }
}
__device__ __forceinline__ void p0_prologue(Frame& F, const Args& a) {
    const bool dyn = F.G == 256;
    if (dyn) { const int v = fresh_s(F.vcu); if (!(v & 1) && (v >> 1) < DEPTH * NG) ssm_tables_unit(F, a, (v >> 1) / NG, (v >> 1) % NG); }
    else for (int u = fresh_s(F.vcu); u < DEPTH * NG; u += F.G) ssm_tables_unit(F, a, u / NG, u % NG);
    const int gw = fresh_s(F.vcu * NWAVES + F.wave), NGW = F.G * NWAVES, lane_ = lane_fresh();
    static_assert((DEPTH * P0_I_PER_L - P0_DEFER) % 256 == 0, "dynamic deal: 32 groups x chunks of 8");
    if (dyn) convert_items<true>(F, a, 0, DEPTH * P0_I_PER_L - P0_DEFER, gw, NGW); else convert_items<false>(F, a, 0, DEPTH * P0_I_PER_L - P0_DEFER, gw, NGW);
    const int gt = gw * 64 + lane_, NT = NGW * 64;
    float* ropec = (float*)(F.ws + WS_ROPEC); float* ropes = (float*)(F.ws + WS_ROPES);
    for (int i = gt; i < SEQ * 8; i += NT) { const int pos = i >> 3, k = i & 7; const float inv = powf(500000.0f, -(float)(2 * k) / 16.0f); const float ang = (float)pos * inv;
        ropec[i] = (float)cos((double)ang); ropes[i] = (float)sin((double)ang); }
    if (gw < DEPTH) { const int l = gw;
        const float s1 = wave_sum(a.in[15][l * HD + lane_] * a.in[16][l * HD + lane_], lane_), s2 = wave_sum(a.in[17][l * HD + lane_] * a.in[18][l * HD + lane_], lane_);
        if (lane_ == 0) ((float*)(F.ws + WS_SCAL))[l] = expf(s1) - expf(s2) + lam_init_of(l); }
    { float* wrt = (float*)(F.ws + WS_WRT);
      for (int i = gt; i < DEPTH * NE * DM; i += NT) { const int l = i / (NE * DM), e = (i / DM) % NE, d = i % DM; wrt[i] = a.in[23][(size_t)l * DM + d] * a.in[24][((size_t)l * DM + d) * NE + e]; } }
}

__device__ __forceinline__ void phase_norm_rows(Frame& F_, const float* xin, float* xout, const bf16* ye, const int* sel, const float* g, bf16* hn, unsigned char* h8 = nullptr) {
    struct { int lane; } F{lane_fresh()};
    const int gw = fresh_s(F_.vcu * NWAVES + F_.wave), NGW = F_.G * NWAVES;
    f32x4 gv[8];
    if (hn) { const GAS f32x4* gr = (const GAS f32x4*)g + F.lane;
#pragma unroll
        for (int j = 0; j < 8; ++j) gv[j] = gr[64 * j]; }
    f32x4 vn[8]; int seln = -1;
    if (gw < SEQ) { const GAS f32x4* xr = (const GAS f32x4*)(xin + (size_t)gw * DM) + F.lane; if (ye) seln = sel[gw * NE + (F.lane & 15)];
#pragma unroll
        for (int j = 0; j < 8; ++j) vn[j] = xr[64 * j]; }
    for (int t = gw; t < SEQ; t += NGW) {
        f32x4 v[8];
#pragma unroll
        for (int j = 0; j < 8; ++j) v[j] = vn[j];
        const int selv = seln;
        { const int tn = t + NGW;
          if (tn < SEQ) { const GAS f32x4* xr = (const GAS f32x4*)(xin + (size_t)tn * DM) + F.lane; if (ye) seln = sel[tn * NE + (F.lane & 15)];
#pragma unroll
              for (int j = 0; j < 8; ++j) vn[j] = xr[64 * j]; } }
        if (ye) {
            unsigned m = (unsigned)(__ballot(selv >= 0) & 0xffffull);
            while (m) { const int e0 = __builtin_ctz(m); m &= m - 1; const int s0 = __builtin_amdgcn_readlane(selv, e0);
                const bool two = m != 0u; const int e1 = two ? __builtin_ctz(m) : e0; if (two) m &= m - 1; const int s1 = __builtin_amdgcn_readlane(selv, e1);
                const GAS v2u* y0 = (const GAS v2u*)(ye + (size_t)(e0 * CAP + s0) * DM) + F.lane; const GAS v2u* y1 = (const GAS v2u*)(ye + (size_t)(e1 * CAP + s1) * DM) + F.lane;
                v2u a[8], b[8];
#pragma unroll
                for (int j = 0; j < 8; ++j) a[j] = y0[64 * j];
                if (two) {
#pragma unroll
                    for (int j = 0; j < 8; ++j) b[j] = y1[64 * j]; }
#pragma unroll
                for (int j = 0; j < 8; ++j) { v[j].x += bflo(a[j].x); v[j].y += bfhi(a[j].x); v[j].z += bflo(a[j].y); v[j].w += bfhi(a[j].y); }
                if (two) {
#pragma unroll
                    for (int j = 0; j < 8; ++j) { v[j].x += bflo(b[j].x); v[j].y += bfhi(b[j].x); v[j].z += bflo(b[j].y); v[j].w += bfhi(b[j].y); } } }
        }
        if (xout) { GAS f32x4* xo = (GAS f32x4*)(xout + (size_t)t * DM) + F.lane;
#pragma unroll
            for (int j = 0; j < 8; ++j) xo[64 * j] = v[j]; }
        if (hn) {
            float ss = 0.f;
#pragma unroll
            for (int j = 0; j < 8; ++j) ss += (v[j].x * v[j].x + v[j].y * v[j].y) + (v[j].z * v[j].z + v[j].w * v[j].w);
            const float rstd = rsqrtf(wave_sum(ss, F.lane) * (1.f / DM) + EPS);
            GAS v2u* o8 = (GAS v2u*)(hn + (size_t)t * DM) + F.lane;
#pragma unroll
            for (int j = 0; j < 8; ++j) { const f32x4 gg = gv[j]; v2u o; o.x = pk2(v[j].x * rstd * gg.x, v[j].y * rstd * gg.y); o.y = pk2(v[j].z * rstd * gg.z, v[j].w * rstd * gg.w); o8[64 * j] = o;
                if (h8) ((GAS unsigned*)(h8 + (size_t)t * DM))[64 * j + F.lane] = pg8::pack4_fp8(v[j].x * rstd * gg.x, v[j].y * rstd * gg.y, v[j].z * rstd * gg.z, v[j].w * rstd * gg.w); }
        }
    }
}
template <class Hook> __device__ __forceinline__ void phase_qknorm(Frame& F, int l, const float* qg, const float* kg, Hook hook) {
    const int gw = fresh_s(F.vcu * NWAVES + F.wave), NGW = F.G * NWAVES, lane = lane_fresh();
    const float* ropec = (const float*)(F.ws + WS_ROPEC); const float* ropes = (const float*)(F.ws + WS_ROPES);
    float* qnrm = (float*)(F.ws + WS_QNRM);
    float kmax = 0.f;
    const int isk = gw & 1;
    float gn[16];
    { const float* gnp = (isk ? kg : qg) + 16 * (lane & 3);
#pragma unroll
      for (int i = 0; i < 16; ++i) gn[i] = gnp[i]; }
    const bf16* sbase = (const bf16*)(F.ws + (isk ? WS_KRAW : WS_QRAW)) + 16 * lane;
    bf16* dbase = (bf16*)(F.ws + (isk ? WS_KN : WS_QN)) + 16 * lane;
    const float sc = isk ? 1.f : QSCALE;
    for (int it0 = gw; it0 < 2 * SEQ; it0 += 4 * NGW) {
        if (it0 != gw) hook();
        v4u w0[4], w1[4]; f32x4 rc0[4], rc1[4], rs0[4], rs1[4];
#pragma unroll
        for (int j = 0; j < 4; ++j) { const int it = it0 + j * NGW;
            if (it < 2 * SEQ) { const int t = it >> 1; const bf16* src = sbase + (size_t)t * DATT;
                w0[j] = *(const GAS v4u*)src; w1[j] = *(const GAS v4u*)(src + 8);
                rc0[j] = *(const GAS f32x4*)(ropec + t * 8); rc1[j] = *(const GAS f32x4*)(ropec + t * 8 + 4); rs0[j] = *(const GAS f32x4*)(ropes + t * 8); rs1[j] = *(const GAS f32x4*)(ropes + t * 8 + 4); } }
#pragma unroll
        for (int j = 0; j < 4; ++j) { const int it = it0 + j * NGW;
            if (it < 2 * SEQ) { const int t = it >> 1; bf16* dst = dbase + (size_t)t * DATT;
                float x[16];
                x[0] = bflo(w0[j].x); x[1] = bfhi(w0[j].x); x[2] = bflo(w0[j].y); x[3] = bfhi(w0[j].y); x[4] = bflo(w0[j].z); x[5] = bfhi(w0[j].z); x[6] = bflo(w0[j].w); x[7] = bfhi(w0[j].w);
                x[8] = bflo(w1[j].x); x[9] = bfhi(w1[j].x); x[10] = bflo(w1[j].y); x[11] = bfhi(w1[j].y); x[12] = bflo(w1[j].z); x[13] = bfhi(w1[j].z); x[14] = bflo(w1[j].w); x[15] = bfhi(w1[j].w);
                float ss = 0.f;
#pragma unroll
                for (int i = 0; i < 16; ++i) ss += x[i] * x[i];
                ss += bperm_f(lane ^ 1, ss); ss += bperm_f(lane ^ 2, ss);
                const float rstd = rsqrtf(ss * (1.f / HD) + EPS);
#pragma unroll
                for (int i = 0; i < 16; ++i) x[i] = x[i] * rstd * gn[i];
                if ((lane & 3) == 0) {
                    const float cv[8] = {rc0[j].x, rc0[j].y, rc0[j].z, rc0[j].w, rc1[j].x, rc1[j].y, rc1[j].z, rc1[j].w}, sv[8] = {rs0[j].x, rs0[j].y, rs0[j].z, rs0[j].w, rs1[j].x, rs1[j].y, rs1[j].z, rs1[j].w};
#pragma unroll
                    for (int i = 0; i < 8; ++i) { const float c = cv[i], s_ = sv[i], x1 = x[i], x2 = x[i + 8]; x[i] = x1 * c - x2 * s_; x[i + 8] = x2 * c + x1 * s_; }
                }
                unsigned o[8]; float n2 = 0.f;
#pragma unroll
                for (int i = 0; i < 8; ++i) { o[i] = pk2(x[2 * i] * sc, x[2 * i + 1] * sc); const float a0 = bflo(o[i]), a1 = bfhi(o[i]); n2 += a0 * a0 + a1 * a1; }
                n2 += bperm_f(lane ^ 1, n2); n2 += bperm_f(lane ^ 2, n2);
                v4u o0, o1; o0.x = o[0]; o0.y = o[1]; o0.z = o[2]; o0.w = o[3]; o1.x = o[4]; o1.y = o[5]; o1.z = o[6]; o1.w = o[7];
                *(GAS v4u*)dst = o0; *(GAS v4u*)(dst + 8) = o1;
                if (isk) kmax = fmaxf(kmax, n2);
                else if ((lane & 3) == 0) qnrm[t * NHH + (lane >> 2)] = sqrtf(n2); } }
    }
    LAS float* red = (LAS float*)(F.lds + RING_OFF);
    __syncthreads();
    if ((lane & 3) == 0) red[F.wave * 16 + (lane >> 2)] = kmax;
    __syncthreads();
    if (F.wave == 0 && lane < NHH) { float m = 0.f;
#pragma unroll
        for (int w = 0; w < NWAVES; ++w) m = fmaxf(m, red[w * 16 + lane]);
        atomicMax((unsigned*)(F.ctl + CW_KMAX + l * NHH + lane), __float_as_uint(m)); }
    __syncthreads();
}
typedef float rf32x4 __attribute__((ext_vector_type(4)));
__device__ __forceinline__ void phase_norm_router(Frame& F, const float* xin, const float* g, const float* wrt, bf16* xn, float* aff) {
    const int lane = lane_fresh(), r = lane & 15, kk = lane >> 4, wave = F.wave, rg = wave & 1, kq = wave >> 1;
    LAS float* lrs = (LAS float*)(F.lds + RING_OFF);
    LAS float* part = lrs + 64;
    for (int base = fresh_s(F.vcu) * 32; base < SEQ; base += F.G * 32) {
        __syncthreads();
        rf32x4 xv[8][4];
        {
            const float* xrow = xin + (size_t)(base + 16 * rg + r) * DM + 512 * kq + 16 * kk;
            const float* wrow = wrt + (size_t)r * DM + 512 * kq + 16 * kk;
            rf32x4 acc = {0.f, 0.f, 0.f, 0.f}; float ss = 0.f;
#pragma unroll
            for (int s8 = 0; s8 < 8; ++s8) {
                rf32x4 wv[4];
#pragma unroll
                for (int i = 0; i < 4; ++i) { xv[s8][i] = *(const GAS rf32x4*)(xrow + 64 * s8 + 4 * i); wv[i] = *(const GAS rf32x4*)(wrow + 64 * s8 + 4 * i); }
#pragma unroll
                for (int i = 0; i < 4; ++i)
#pragma unroll
                    for (int j = 0; j < 4; ++j) { acc = __builtin_amdgcn_mfma_f32_16x16x4f32(xv[s8][i][j], wv[i][j], acc, 0, 0, 0); ss += xv[s8][i][j] * xv[s8][i][j]; }
            }
            LAS float* pp = part + (wave * 64 + lane) * 5;
            pp[0] = acc[0]; pp[1] = acc[1]; pp[2] = acc[2]; pp[3] = acc[3]; pp[4] = ss;
        }
        __syncthreads();
        if (wave < 2) {
            rf32x4 acc = {0.f, 0.f, 0.f, 0.f}; float ss = 0.f;
#pragma unroll
            for (int q = 0; q < 4; ++q) { const LAS float* pp = part + ((2 * q + wave) * 64 + lane) * 5; acc[0] += pp[0]; acc[1] += pp[1]; acc[2] += pp[2]; acc[3] += pp[3]; ss += pp[4]; }
            ss += bperm_f(lane ^ 16, ss); ss += bperm_f(lane ^ 32, ss);
            const float rstd = rsqrtf(ss * (1.f / DM) + EPS);
            if (lane < 16) lrs[16 * wave + lane] = rstd;
#pragma unroll
            for (int q = 0; q < 4; ++q) { const int row = 4 * kk + q; const float lg = acc[q] * bperm_f(row, rstd);
                float m = lg; m = fmaxf(m, bperm_f(lane ^ 1, m)); m = fmaxf(m, bperm_f(lane ^ 2, m)); m = fmaxf(m, bperm_f(lane ^ 4, m)); m = fmaxf(m, bperm_f(lane ^ 8, m));
                const float p = expf(lg - m); float sm = p; sm += bperm_f(lane ^ 1, sm); sm += bperm_f(lane ^ 2, sm); sm += bperm_f(lane ^ 4, sm); sm += bperm_f(lane ^ 8, sm);
                aff[(size_t)(base + 16 * wave + row) * NE + r] = p / sm; }
        }
        __syncthreads();
        { const float rstd = lrs[16 * rg + r];
          GAS v4u* o16 = (GAS v4u*)((unsigned char*)xn + (size_t)(base + 16 * rg + r) * DM + 512 * kq + 16 * kk); const GAS rf32x4* gp = (const GAS rf32x4*)(g + 512 * kq + 16 * kk);
#pragma unroll
          for (int s8 = 0; s8 < 8; ++s8) { v4u w;
#pragma unroll
              for (int i = 0; i < 4; ++i) { const rf32x4 gg = gp[16 * s8 + i]; const rf32x4 v = xv[s8][i]; const unsigned pw_ = pg8::pack4_fp8(v[0] * rstd * gg[0], v[1] * rstd * gg[1], v[2] * rstd * gg[2], v[3] * rstd * gg[3]);
                  if (i == 0) w.x = pw_; else if (i == 1) w.y = pw_; else if (i == 2) w.z = pw_; else w.w = pw_; }
              o16[4 * s8] = w; } }
    }
    __syncthreads();
}
__device__ __forceinline__ int block_excl_scan(int v, LAS int* tmp, int lane, int wave, int& total) {
    int incl = v;
#pragma unroll
    for (int o = 1; o < 64; o <<= 1) { const int n = bperm_i(lane - o, incl); if (lane >= o) incl += n; }
    __syncthreads();
    if (lane == 63) tmp[wave] = incl;
    __syncthreads();
    int woff = 0, tot = 0;
#pragma unroll
    for (int w = 0; w < NWAVES; ++w) { const int x = tmp[w]; if (w < wave) woff += x; tot += x; }
    total = tot;
    return woff + incl - v;
}
__device__ __forceinline__ void phase_topk(Frame& F, const float* aff, int* sel, int* idx, float* gwt) {
    LAS int* hist = (LAS int*)(F.lds + RING_OFF);
    LAS int* ctl = hist + NWAVES * 256;
    LAS int* tmp = ctl + 16;
    const int lane = lane_fresh(), wave = F.wave, tid = wave * 64 + lane;
    for (int e = fresh_s(F.vcu); e < NE; e += F.G) {
        unsigned key[16];
#pragma unroll
        for (int i = 0; i < 16; ++i) key[i] = __float_as_uint(aff[(size_t)(tid * 16 + i) * NE + e]);
        unsigned prefix = 0u; int need = CAP;
#pragma unroll 1
        for (int rnd = 3; rnd >= 0; --rnd) {
            const int sh = 8 * rnd; const unsigned himask = rnd == 3 ? 0u : (0xffffffffu << (sh + 8));
            __syncthreads();
            for (int i = tid; i < NWAVES * 256; i += NWAVES * 64) hist[i] = 0;
            __syncthreads();
#pragma unroll
            for (int i = 0; i < 16; ++i) if ((key[i] & himask) == prefix) __hip_atomic_fetch_add(&hist[wave * 256 + ((key[i] >> sh) & 255u)], 1, __ATOMIC_RELAXED, __HIP_MEMORY_SCOPE_WORKGROUP);
            __syncthreads();
            if (wave == 0) {
                const int b0 = 255 - 4 * lane; int h0 = 0, h1 = 0, h2 = 0, h3 = 0;
#pragma unroll
                for (int w = 0; w < NWAVES; ++w) { h0 += hist[w * 256 + b0]; h1 += hist[w * 256 + b0 - 1]; h2 += hist[w * 256 + b0 - 2]; h3 += hist[w * 256 + b0 - 3]; }
                const int mine = h0 + h1 + h2 + h3; int incl = mine;
#pragma unroll
                for (int o = 1; o < 64; o <<= 1) { const int n = bperm_i(lane - o, incl); if (lane >= o) incl += n; }
                const int before = incl - mine;
                if (before < need && need <= incl) { int c = before, b = b0, hsel = h0;
                    if (need > c + h0) { c += h0; b = b0 - 1; hsel = h1; if (need > c + h1) { c += h1; b = b0 - 2; hsel = h2; if (need > c + h2) { c += h2; b = b0 - 3; hsel = h3; } } }
                    (void)hsel; ctl[0] = (int)(prefix | ((unsigned)b << sh)); ctl[1] = need - c; }
            }
            __syncthreads();
            prefix = (unsigned)ctl[0]; need = ctl[1];
        }
        int neq = 0;
#pragma unroll
        for (int i = 0; i < 16; ++i) neq += (key[i] == prefix) ? 1 : 0;
        int tot; int eqr = block_excl_scan(neq, tmp, lane, wave, tot);
        int nsel = 0; unsigned selmask = 0u;
#pragma unroll
        for (int i = 0; i < 16; ++i) { bool s = key[i] > prefix; if (key[i] == prefix) { s = eqr < need; ++eqr; } if (s) { selmask |= 1u << i; ++nsel; } }
        int slot = block_excl_scan(nsel, tmp, lane, wave, tot);
#pragma unroll
        for (int i = 0; i < 16; ++i) { const int t = tid * 16 + i; const bool s = (selmask >> i) & 1u;
            sel[(size_t)t * NE + e] = s ? slot : -1;
            if (s) { idx[e * CAP + slot] = t; gwt[e * CAP + slot] = __uint_as_float(key[i]); ++slot; } }
    }
    __syncthreads();
}
__device__ __forceinline__ void phase_gather8(Frame& F, const unsigned char* xn8, const int* idx, unsigned char* xe8) {
    const int gw = fresh_s(F.vcu * NWAVES + F.wave), NGW = F.G * NWAVES, lane = lane_fresh();
    for (int rb = gw; rb < NE * CAP; rb += 8 * NGW) {
        const int myr = rb + (lane & 7) * NGW; const int iv = myr < NE * CAP ? idx[myr] : 0;
        v4u a[8], b[8];
#pragma unroll
        for (int j = 0; j < 8; ++j) { const int r = rb + j * NGW;
            if (r < NE * CAP) { const int t = __builtin_amdgcn_readlane(iv, j); const GAS v4u* s = (const GAS v4u*)(xn8 + (size_t)t * DM) + lane; a[j] = s[0]; b[j] = s[64]; } }
#pragma unroll
        for (int j = 0; j < 8; ++j) { const int r = rb + j * NGW;
            if (r < NE * CAP) { GAS v4u* d = (GAS v4u*)(xe8 + (size_t)r * DM) + lane; d[0] = a[j]; d[64] = b[j]; } }
    }
}
__device__ __forceinline__ void phase_gather(Frame& F, const bf16* xn, const int* idx, bf16* xe) {
    const int gw = fresh_s(F.vcu * NWAVES + F.wave), NGW = F.G * NWAVES, lane = lane_fresh();
    for (int r = gw; r < NE * CAP; r += NGW) { const int t = __builtin_amdgcn_readfirstlane(idx[r]);
        const GAS v4u* s = (const GAS v4u*)(xn + (size_t)t * DM) + lane; GAS v4u* d = (GAS v4u*)(xe + (size_t)r * DM) + lane;
#pragma unroll
        for (int j = 0; j < 4; ++j) d[64 * j] = s[64 * j]; }
}

__device__ __forceinline__ float gelu_tanh(float x) {
    const float z = 0.7978845608028654f * (x + 0.044715f * x * x * x);
    const float th = 1.f - 2.f / (1.f + __expf(2.f * z));
    return 0.5f * x * (1.f + th);
}

#ifndef USE_FAST_SSM
#define USE_FAST_SSM 1
#endif
#ifndef USE_FAST_ATTN
#define USE_FAST_ATTN 1
#endif
constexpr size_t WS_LAM16 = WS_LAMB + 512 * 1024;
constexpr size_t WS_SSMTOT = WS_LAMB;
constexpr int SSM_SROW = 264;
typedef short abf16x8 __attribute__((ext_vector_type(8)));
typedef short as16x4 __attribute__((ext_vector_type(4)));
typedef float af32x16 __attribute__((ext_vector_type(16)));
struct cf2 { float x, y; };
__device__ __forceinline__ cf2 ldc_(const LAS float* p, int i) { cf2 r; r.x = p[2 * i]; r.y = p[2 * i + 1]; return r; }
#define LDC(arr, i) ldc_((arr), (i))

__device__ __forceinline__ void ssm_tables_unit(Frame& F, const Args& a, int l, int g) {
    LAS float* lamp = (LAS float*)(F.lds + RING_OFF);
    LAS float* bb = lamp + 2 * 2 * 17 * 64;
    LAS float* cc = bb + 2 * 2 * 64 * 16;
    LAS float* kk = cc + 2 * 2 * 16 * 64;
    const int tid = F.wave * 64 + lane_fresh();
    __syncthreads();
    if (tid < 128) { const int dir = tid >> 6, p = tid & 63; const int gb = (l * 2 + dir) * NG + g, i = gb * SP + p;
        const double ar = a.in[4][i], ai = a.in[5][i], st = exp((double)a.in[6][gb]);
        const double er = exp(ar * st), lr = er * cos(ai * st), li = er * sin(ai * st);
        const double xr = lr - 1.0, xi = li, den = ar * ar + ai * ai, qr = (xr * ar + xi * ai) / den, qi = (xi * ar - xr * ai) / den;
        double pr = 1.0, pi = 0.0;
        for (int d = 0; d <= 16; ++d) { lamp[2 * ((dir * 17 + d) * 64 + p)] = (float)pr; lamp[2 * ((dir * 17 + d) * 64 + p) + 1] = (float)pi;
            if (d == 16) ((float2*)(F.ws + WS_LAM16))[i] = make_float2((float)pr, (float)pi);
            const double nr = pr * lr - pi * li, ni = pr * li + pi * lr; pr = nr; pi = ni; }
        for (int h = 0; h < SG; ++h) { const double br = a.in[7][(size_t)i * SG + h], bi = a.in[8][(size_t)i * SG + h];
            bb[2 * ((dir * 64 + p) * 16 + h)] = (float)(qr * br - qi * bi); bb[2 * ((dir * 64 + p) * 16 + h) + 1] = (float)(qr * bi + qi * br); }
    }
    for (int e = tid; e < 2048; e += NWAVES * 64) { const int dir = e >> 10, h = (e >> 6) & 15, p = e & 63; const size_t idx = ((size_t)((l * 2 + dir) * NG + g) * SG + h) * SP + p;
        cc[2 * e] = a.in[9][idx]; cc[2 * e + 1] = a.in[10][idx]; }
    __syncthreads();
    { const int lane_ = tid & 63, wv_ = tid >> 6, dir = wv_ >> 2, dq = (wv_ & 3) * 4, m = lane_ & 15, q = lane_ >> 4;
      typedef float tf32x4 __attribute__((ext_vector_type(4)));
      tf32x4 acc[4];
#pragma unroll
      for (int dd = 0; dd < 4; ++dd) acc[dd] = tf32x4{0.f, 0.f, 0.f, 0.f};
#pragma unroll 4
      for (int st = 0; st < 32; ++st) { const int p = 2 * st + (q >> 1); const bool im = q & 1;
          const cf2 c = LDC(cc, (dir * 16 + m) * 64 + p), b = LDC(bb, (dir * 64 + p) * 16 + m);
          const float bv = im ? b.y : b.x;
#pragma unroll
          for (int dd = 0; dd < 4; ++dd) { const cf2 L = LDC(lamp, (dir * 17 + dq + dd) * 64 + p);
              const float av = im ? -(c.x * L.y + c.y * L.x) : (c.x * L.x - c.y * L.y);
              acc[dd] = __builtin_amdgcn_mfma_f32_16x16x4f32(av, bv, acc[dd], 0, 0, 0); } }
#pragma unroll
      for (int dd = 0; dd < 4; ++dd)
#pragma unroll
          for (int j = 0; j < 4; ++j) kk[((dir * 16 + dq + dd) * 16 + (4 * q + j)) * 16 + m] = acc[dd][j]; }
    __syncthreads();
    unsigned* em = (unsigned*)((bf16*)(F.ws + WS_EMAT) + (size_t)(l * NG + g) * 65536);
    for (int e = tid; e < 32768; e += NWAVES * 64) { const int j = e >> 7, k = (e & 127) * 2, dir = j >> 7, ri = (j >> 6) & 1, p = j & 63, s = k >> 4, h = k & 15;
        const cf2 L = LDC(lamp, (dir * 17 + (dir ? s : 15 - s)) * 64 + p), b0 = LDC(bb, (dir * 64 + p) * 16 + h), b1 = LDC(bb, (dir * 64 + p) * 16 + h + 1);
        const float v0 = ri ? (L.x * b0.y + L.y * b0.x) : (L.x * b0.x - L.y * b0.y), v1 = ri ? (L.x * b1.y + L.y * b1.x) : (L.x * b1.x - L.y * b1.y);
        em[e] = pk2(v0, v1); }
    unsigned* wm = (unsigned*)((bf16*)(F.ws + WS_WMAT) + (size_t)(l * NG + g) * 131072);
    const float* dsk = a.in[11] + (size_t)l * DSSM + g * SG;
    for (int e = tid; e < 32768; e += NWAVES * 64) { const int n = e >> 7, kp = e & 127, t = n >> 4, h = n & 15, s = kp >> 3, h2 = 2 * (kp & 7); float v0 = 0.f, v1 = 0.f;
        if (s <= t) { const LAS float* q = kk + ((0 * 16 + (t - s)) * 16 + h) * 16 + h2; v0 += q[0]; v1 += q[1]; }
        if (s >= t) { const LAS float* q = kk + ((1 * 16 + (s - t)) * 16 + h) * 16 + h2; v0 += q[0]; v1 += q[1]; }
        if (s == t) { if (h == h2) v0 += dsk[h]; else if (h == h2 + 1) v1 += dsk[h]; }
        wm[n * 256 + kp] = pk2(v0, v1); }
    for (int e = tid; e < 32768; e += NWAVES * 64) { const int n = e >> 7, kp = e & 127, t = n >> 4, h = n & 15, dir = kp >> 6, ri = (kp >> 5) & 1, p = 2 * (kp & 31);
        const int ci = (dir * 16 + h) * 64 + p, li = (dir * 17 + (dir ? 16 - t : t + 1)) * 64 + p;
        const cf2 c0 = LDC(cc, ci), c1 = LDC(cc, ci + 1), L0 = LDC(lamp, li), L1 = LDC(lamp, li + 1);
        const float v0 = ri ? -(c0.x * L0.y + c0.y * L0.x) : (c0.x * L0.x - c0.y * L0.y), v1 = ri ? -(c1.x * L1.y + c1.y * L1.x) : (c1.x * L1.x - c1.y * L1.y);
        wm[n * 256 + 128 + kp] = pk2(v0, v1); }
    __syncthreads();
}
__device__ __forceinline__ void ssm_e_unit(Frame& F, int l, int g, int part) {
    const int lane = lane_fresh(), r32 = lane & 31, hh = lane >> 5, wm = F.wave & 3, wn = F.wave >> 2;
    const bf16* em = (const bf16*)(F.ws + WS_EMAT) + (size_t)(l * NG + g) * 65536;
    float* E = (float*)(F.ws + WS_SSME) + (size_t)g * 512 * 256;
    const int c0 = part * 128 + wm * 32;
    af32x16 acc[4];
#pragma unroll
    for (int nb = 0; nb < 4; ++nb) acc[nb] = af32x16{};
    const bf16* ap = (const bf16*)(F.ws + WS_U) + ((size_t)g * SEQ + 16 * (c0 + r32)) * SG + 8 * hh;
    const bf16* bp = em + (size_t)(wn * 128 + r32) * 256 + 8 * hh;
#pragma unroll 1
    for (int kg = 0; kg < 4; ++kg) {
        abf16x8 av[4], bv[4][4];
#pragma unroll
        for (int j = 0; j < 4; ++j) { av[j] = *(const GAS abf16x8*)(ap + (kg * 4 + j) * SG);
#pragma unroll
            for (int nb = 0; nb < 4; ++nb) bv[j][nb] = *(const GAS abf16x8*)(bp + (size_t)nb * 32 * 256 + (kg * 4 + j) * 16); }
        __builtin_amdgcn_sched_barrier(0);
#pragma unroll
        for (int j = 0; j < 4; ++j)
#pragma unroll
            for (int nb = 0; nb < 4; ++nb) acc[nb] = __builtin_amdgcn_mfma_f32_32x32x16_bf16(av[j], bv[j][nb], acc[nb], 0, 0, 0);
        __builtin_amdgcn_sched_barrier(0);
    }
    LAS float* el = (LAS float*)(F.lds + RING_OFF);
    __syncthreads();
#pragma unroll
    for (int nb = 0; nb < 4; ++nb)
#pragma unroll
        for (int i = 0; i < 16; ++i) { const int row = (i & 3) + 8 * (i >> 2) + 4 * hh; el[(wm * 32 + row) * 256 + wn * 128 + nb * 32 + r32] = acc[nb][i]; }
    __syncthreads();
    { const int dir = F.wave & 1, seg = F.wave >> 1;
        const float2 L = ((const float2*)(F.ws + WS_LAM16))[((l * 2 + dir) * NG + g) * SP + lane];
        const LAS float* ep = el + dir * 128 + lane; float* eo = E + (size_t)(part * 128) * 256 + dir * 128 + lane;
        LAS float* xs = el + 128 * 256;
        float vr[32], vi[32];
#pragma unroll
        for (int kk_ = 0; kk_ < 32; ++kk_) { const int k = 32 * seg + kk_, c = dir ? 127 - k : k; vr[kk_] = ep[c * 256]; vi[kk_] = ep[c * 256 + 64]; }
        float sr = 0.f, si = 0.f;
#pragma unroll
        for (int kk_ = 0; kk_ < 32; ++kk_) { const float nr = L.x * sr - L.y * si + vr[kk_], ni = L.x * si + L.y * sr + vi[kk_]; sr = nr; si = ni; vr[kk_] = sr; vi[kk_] = si; }
        xs[((dir * 4 + seg) * 64 + lane) * 2] = sr; xs[((dir * 4 + seg) * 64 + lane) * 2 + 1] = si;
        float pr32 = L.x, pi32 = L.y;
#pragma unroll
        for (int q = 0; q < 5; ++q) { const float nr = pr32 * pr32 - pi32 * pi32, ni = 2.f * pr32 * pi32; pr32 = nr; pi32 = ni; }
        __syncthreads();
        float cr = 0.f, ci = 0.f;
#pragma unroll
        for (int j = 0; j < 3; ++j) if (j < seg) { const float tr = xs[((dir * 4 + j) * 64 + lane) * 2], ti = xs[((dir * 4 + j) * 64 + lane) * 2 + 1];
            const float nr = pr32 * cr - pi32 * ci + tr, ni = pr32 * ci + pi32 * cr + ti; cr = nr; ci = ni; }
        float pr = L.x, pi = L.y;
#pragma unroll
        for (int kk_ = 0; kk_ < 32; ++kk_) { const int k = 32 * seg + kk_, c = dir ? 127 - k : k;
            sr = vr[kk_] + pr * cr - pi * ci; si = vi[kk_] + pr * ci + pi * cr;
            eo[(size_t)c * 256] = sr; eo[(size_t)c * 256 + 64] = si;
            const float nr = pr * L.x - pi * L.y, ni = pr * L.y + pi * L.x; pr = nr; pi = ni; }
        if (seg == 3) { float* tot = (float*)(F.ws + WS_SSMTOT) + ((size_t)g * 4 + part) * 256 + dir * 128 + lane; tot[0] = sr; tot[64] = si; }
    }
    __syncthreads();
}
__device__ __forceinline__ float gelu_tanh_f(float x) {
    const float z = 0.7978845608028654f * (x + 0.044715f * x * x * x);
    const float th = 1.f - 2.f * __builtin_amdgcn_rcpf(1.f + __builtin_amdgcn_exp2f(2.8853900817779268f * z));
    return 0.5f * x * (1.f + th);
}
constexpr int SSM_APITCH = 520;
__device__ __forceinline__ void ssm_y_unit(Frame& F, int l, int g, int part) {
    const int lane = lane_fresh(), tid = F.wave * 64 + lane, r32 = lane & 31, hh = lane >> 5;
    LAS bf16* ai = (LAS bf16*)(F.lds + RING_OFF);
    const float* E = (const float*)(F.ws + WS_SSME) + (size_t)g * 512 * 256;
    const int c0p = part * 128;
    __syncthreads();
    { const bf16* U = (const bf16*)(F.ws + WS_U) + ((size_t)g * SEQ + 16 * c0p) * SG;
#pragma unroll
      for (int q = 0; q < 8; ++q) { const int idx = tid + q * 512, c = idx >> 5, sh = idx & 31;
          const v4u w = *(const GAS v4u*)(U + (size_t)idx * 8);
          *(LAS v4u*)(ai + c * SSM_APITCH + sh * 8) = w; } }
    const bf16* bp = (const bf16*)(F.ws + WS_WMAT) + (size_t)(l * NG + g) * 131072 + (size_t)(F.wave * 32 + r32) * 512 + 8 * hh;
    abf16x8 bvA[8], bvB[8];
#define Y_LOAD(BV, kg) do { _Pragma("unroll") for (int j = 0; j < 8; ++j) BV[j] = *(const GAS abf16x8*)(bp + ((kg) * 8 + j) * 16); } while (0)
    Y_LOAD(bvA, 0);
    { const int dir = F.wave & 1, hq = F.wave >> 1;
        const float2 L = ((const float2*)(F.ws + WS_LAM16))[((l * 2 + dir) * NG + g) * SP + lane];
        float qr = L.x, qi = L.y, tr32 = 0.f, ti32 = 0.f;
#pragma unroll
        for (int q = 0; q < 7; ++q) { if (q == 5) { tr32 = qr; ti32 = qi; } const float nr = qr * qr - qi * qi, ni = 2.f * qr * qi; qr = nr; qi = ni; }
        const float* tot = (const float*)(F.ws + WS_SSMTOT) + (size_t)g * 4 * 256 + dir * 128 + lane;
        float cr = 0.f, ci = 0.f;
        float ttr[4], tti[4];
#pragma unroll
        for (int pp = 0; pp < 4; ++pp) { ttr[pp] = tot[pp * 256]; tti[pp] = tot[pp * 256 + 64]; }
        const float* ep = E + (size_t)c0p * 256 + dir * 128 + lane;
        const int k0 = 32 * hq, kend = hq == 3 ? 127 : k0 + 32;
        float ev_r[32], ev_i[32];
#pragma unroll
        for (int kk_ = 0; kk_ < 32; ++kk_) { const int k = k0 + kk_; if (k < kend) { const int src = dir ? 127 - k : k; ev_r[kk_] = ep[(size_t)src * 256]; ev_i[kk_] = ep[(size_t)src * 256 + 64]; } else { ev_r[kk_] = 0.f; ev_i[kk_] = 0.f; } }
        if (dir == 0) {
#pragma unroll
            for (int pp = 0; pp < 3; ++pp) if (pp < part) { const float nr = qr * cr - qi * ci + ttr[pp], ni = qr * ci + qi * cr + tti[pp]; cr = nr; ci = ni; } }
        else {
#pragma unroll
            for (int pp = 3; pp > 0; --pp) if (pp > part) { const float nr = qr * cr - qi * ci + ttr[pp], ni = qr * ci + qi * cr + tti[pp]; cr = nr; ci = ni; } }
        LAS bf16* so = ai + 256 + dir * 128 + lane;
        if (hq == 0) { so[(dir ? 127 : 0) * SSM_APITCH] = (bf16)f2bf(cr); so[(dir ? 127 : 0) * SSM_APITCH + 64] = (bf16)f2bf(ci); }
        float pr = L.x, pi = L.y;
#pragma unroll
        for (int i = 0; i < 3; ++i) if (i < hq) { const float nr = pr * tr32 - pi * ti32, ni = pr * ti32 + pi * tr32; pr = nr; pi = ni; }
#pragma unroll
        for (int kk_ = 0; kk_ < 32; ++kk_) { const int k = k0 + kk_;
            if (k < kend) { const int dst = dir ? 126 - k : k + 1; const float er = ev_r[kk_], ei = ev_i[kk_];
                so[dst * SSM_APITCH] = (bf16)f2bf(er + pr * cr - pi * ci); so[dst * SSM_APITCH + 64] = (bf16)f2bf(ei + pr * ci + pi * cr);
                const float nr = pr * L.x - pi * L.y, ni = pr * L.y + pi * L.x; pr = nr; pi = ni; } }
    }
    Y_LOAD(bvB, 1);
    __syncthreads();
    const LAS bf16* ap = ai + r32 * SSM_APITCH + 8 * hh;
    af32x16 acc[4];
#pragma unroll
    for (int mb = 0; mb < 4; ++mb) acc[mb] = af32x16{};
#define Y_MMA(BV, kg) do { _Pragma("unroll") for (int j = 0; j < 8; ++j) _Pragma("unroll") for (int mb = 0; mb < 4; ++mb) { \
        const abf16x8 av = *(const LAS abf16x8*)(ap + mb * 32 * SSM_APITCH + ((kg) * 8 + j) * 16); acc[mb] = __builtin_amdgcn_mfma_f32_32x32x16_bf16(av, BV[j], acc[mb], 0, 0, 0); } } while (0)
    __builtin_amdgcn_sched_barrier(0);
    Y_MMA(bvA, 0); __builtin_amdgcn_sched_barrier(0); Y_LOAD(bvA, 2); __builtin_amdgcn_sched_barrier(0);
    Y_MMA(bvB, 1); __builtin_amdgcn_sched_barrier(0); Y_LOAD(bvB, 3); __builtin_amdgcn_sched_barrier(0);
    Y_MMA(bvA, 2); __builtin_amdgcn_sched_barrier(0);
    Y_MMA(bvB, 3); __builtin_amdgcn_sched_barrier(0);
#undef Y_LOAD
#undef Y_MMA
    bf16* YS = (bf16*)(F.ws + WS_YS);
    const int n = F.wave * 32 + r32, t = n >> 4, h = n & 15;
    __syncthreads();
    LAS bf16* ot = (LAS bf16*)(F.lds + RING_OFF);
#pragma unroll
    for (int mb = 0; mb < 4; ++mb)
#pragma unroll
        for (int i = 0; i < 16; ++i) { const int row = (i & 3) + 8 * (i >> 2) + 4 * hh; ot[(16 * (mb * 32 + row) + t) * 16 + h] = (bf16)f2bf(gelu_tanh_f(acc[mb][i])); }
    __syncthreads();
#pragma unroll
    for (int q = 0; q < 8; ++q) { const int idx = tid + q * 512; const v4u w = *(const LAS v4u*)(ot + idx * 8);
        *(GAS v4u*)(YS + (size_t)(16 * c0p + (idx >> 1)) * DSSM + g * SG + (idx & 1) * 8) = w; }
    __syncthreads();
}

namespace att {
constexpr int KSLOT = 8192, VSLOT = 16384, NS = 3;
constexpr int LDS_K = 0, LDS_V = 4 * KSLOT, LDS_WS = LDS_V + NS * VSLOT, LDS_BYTES_ = LDS_WS + NWAVES * 512;
__device__ __forceinline__ int crow(int r, int hi) { return (r & 3) + 8 * (r >> 2) + 4 * hi; }
typedef short v4i16_t __attribute__((ext_vector_type(4)));
__device__ __forceinline__ as16x4 vtr(const LAS char* p) { return __builtin_bit_cast(as16x4, __builtin_amdgcn_ds_read_tr16_b64_v4i16((LAS v4i16_t*)p)); }
__device__ __forceinline__ void glds16(const void* gsrc, unsigned lds_dst) { unsigned keep;
    asm volatile("s_mov_b32 %0, m0\n\ts_mov_b32 m0, %2\n\ts_nop 0\n\tglobal_load_lds_dwordx4 %1, off\n\ts_mov_b32 m0, %0" : "=&s"(keep) : "v"(gsrc), "s"(lds_dst) : "memory"); }
template <int IMM> __device__ __forceinline__ void glds16s(const void* sbase, unsigned voff, unsigned lds_dst) { unsigned keep;
    asm volatile("s_mov_b32 %0, m0\n\ts_mov_b32 m0, %3\n\ts_nop 0\n\tglobal_load_lds_dwordx4 %1, %2 offset:%4\n\ts_mov_b32 m0, %0" : "=&s"(keep) : "v"(voff), "s"(sbase), "s"(lds_dst), "n"(IMM) : "memory"); }
__device__ __forceinline__ unsigned pkbf(float lo, float hi) { pg8::f32x2_t v = {lo, hi}; pg8::bf16x2_t b = __builtin_convertvector(v, pg8::bf16x2_t); return __builtin_bit_cast(unsigned, b); }
}
__device__ __forceinline__ void attn_unit(Frame& F, const Args& a, int l, int h, int qb) {
    using namespace att;
    const int wid = F.wave;
    LAS char* shm = (LAS char*)(F.lds + RING_OFF);
    const unsigned lds0 = (unsigned)(uintptr_t)shm;
    const int q0 = qb * 256 + wid * 32;
#define ATT_BAR() asm volatile("s_waitcnt lgkmcnt(0)\n\ts_barrier" ::: "memory")
#define ATT_BARK() asm volatile("s_waitcnt lgkmcnt(2)\n\ts_barrier" ::: "memory")
#define ATT_SB() __builtin_amdgcn_sched_barrier(0)
    for (int c = 0; c < 2; ++c) {
        const int lane = lane_fresh(), r32 = lane & 31, hi = lane >> 5;
        const int vrd = ((lane >> 4) & 1) * 32 + (lane & 3) * 8 + (4 * hi + ((lane & 15) >> 2)) * 64, krd = r32 * 128 + ((hi ^ ((r32 >> 1) & 7)) << 4);
        const int hh = 2 * h + c;
        const GAS unsigned char* kbase = F.ws + WS_KN + (size_t)(hh * 64 + 8 * wid * DATT) * 2;
        const GAS unsigned char* vbase = F.ws + WS_V + (size_t)(h * 128 + (wid >> 2) * 32 + 16 * (wid & 3) * DATT) * 2;
        const unsigned koff = (unsigned)(lane >> 3) * (DATT * 2) + (unsigned)(((lane & 7) ^ ((4 * wid + (lane >> 4)) & 7)) << 4), voff = (unsigned)(lane >> 2) * (DATT * 2) + (unsigned)(lane & 3) * 16;
#define ATT_DMA_K(t, s) glds16s<0>((const void*)(kbase + (size_t)(t) * 64 * DATT * 2), koff, (unsigned)__builtin_amdgcn_readfirstlane((int)(lds0 + LDS_K + (s) * KSLOT + wid * 1024)))
#define ATT_DMA_V0(t, s) glds16s<0>((const void*)(vbase + (size_t)(t) * 64 * DATT * 2), voff, (unsigned)__builtin_amdgcn_readfirstlane((int)(lds0 + LDS_V + (s) * VSLOT + wid * 1024)))
#define ATT_DMA_V1(t, s) glds16s<128>((const void*)(vbase + (size_t)(t) * 64 * DATT * 2), voff, (unsigned)__builtin_amdgcn_readfirstlane((int)(lds0 + LDS_V + (s) * VSLOT + (wid + 8) * 1024 - 128)))
#define ATT_DMA_V(t, s) do { const GAS unsigned char* vb_ = vbase + (size_t)(t) * 64 * DATT * 2; \
        glds16s<0>((const void*)vb_, voff, (unsigned)__builtin_amdgcn_readfirstlane((int)(lds0 + LDS_V + (s) * VSLOT + wid * 1024))); \
        glds16s<128>((const void*)vb_, voff, (unsigned)__builtin_amdgcn_readfirstlane((int)(lds0 + LDS_V + (s) * VSLOT + (wid + 8) * 1024 - 128)));   } while (0)
#define ATT_QK(P0_, P1_, s) do { const LAS char* kp_ = shm + LDS_K + (s) * KSLOT + krd; P0_ = af32x16{}; P1_ = af32x16{}; \
        _Pragma("unroll") for (int d0 = 0; d0 < 4; ++d0) { const LAS char* kq_ = (const LAS char*)((unsigned)(uintptr_t)kp_ ^ (unsigned)(d0 << 5)); const abf16x8 b0 = *(const LAS abf16x8*)(kq_), b1 = *(const LAS abf16x8*)(kq_ + 4096); \
            P0_ = __builtin_amdgcn_mfma_f32_32x32x16_bf16(b0, qr[d0], P0_, 0, 0, 0); P1_ = __builtin_amdgcn_mfma_f32_32x32x16_bf16(b1, qr[d0], P1_, 0, 0, 0); } } while (0)
        ATT_DMA_K(0, 0); ATT_DMA_V(0, 0); ATT_DMA_K(1, 1); ATT_DMA_V(1, 1); ATT_DMA_K(2, 2); ATT_DMA_K(3, 3);
        abf16x8 qr[4];
        { const bf16* Qw = (const bf16*)(F.ws + WS_QN) + (size_t)q0 * DATT + hh * 64;
#pragma unroll
          for (int d0 = 0; d0 < 4; ++d0) qr[d0] = *(const GAS abf16x8*)(Qw + (size_t)r32 * DATT + d0 * 16 + hi * 8); }
        const float kmx = __uint_as_float(__hip_atomic_load((unsigned*)(F.ctl + CW_KMAX + l * NHH + hh), RLX_AGENT));
        const float M = ((const float*)(F.ws + WS_QNRM))[(q0 + r32) * NHH + hh] * sqrtf(kmx) * 1.002f + 0.01f;
        af32x16 o[4];
#pragma unroll
        for (int d0 = 0; d0 < 4; ++d0) o[d0] = af32x16{};
        float l_reg = 0.f; int slot = 0;
        asm volatile("s_waitcnt vmcnt(0)" ::: "memory");
        ATT_BAR();
        af32x16 pA0, pA1, pB0, pB1;
        ATT_QK(pA0, pA1, 0);
        const bool use_m = __builtin_amdgcn_readfirstlane((int)(__ballot(M > 64.f) != 0ull)) != 0;
        const float M0 = use_m ? M : 0.f;
#pragma unroll
        for (int r = 0; r < 16; ++r) { pA0[r] = __builtin_amdgcn_exp2f(pA0[r] - M0); pA1[r] = __builtin_amdgcn_exp2f(pA1[r] - M0); }
        as16x4 vlo[8], vhi[8]; abf16x8 kf[4]; pg8::u32x4 pw[4];
#define VRD(f) do { vlo[(f) & 7] = vtr(vp + ((f) & 3) * 4096 + ((f) >> 2) * 1024); vhi[(f) & 7] = vtr(vp + ((f) & 3) * 4096 + ((f) >> 2) * 1024 + 512); } while (0)
#define VFR(f) ((abf16x8){vlo[(f) & 7][0], vlo[(f) & 7][1], vlo[(f) & 7][2], vlo[(f) & 7][3], vhi[(f) & 7][0], vhi[(f) & 7][1], vhi[(f) & 7][2], vhi[(f) & 7][3]})
#define PIN(x) asm volatile("" : "+v"(x))
#define KRD(i) kf[(i) & 3] = *(const LAS abf16x8*)((const LAS char*)((unsigned)(uintptr_t)kp ^ (unsigned)(((i) >> 1) << 5)) + ((i) & 1) * 4096)
#define GA(i, P, C, HN) do { VRD(i); if (HN && (i) + 2 < 8) KRD((i) + 2); ATT_SB(); \
            if (HN) { if ((i) < 2) C = __builtin_amdgcn_mfma_f32_32x32x16_bf16(kf[(i) & 3], qr[(i) >> 1], af32x16{}, 0, 0, 0); else C = __builtin_amdgcn_mfma_f32_32x32x16_bf16(kf[(i) & 3], qr[(i) >> 1], C, 0, 0, 0); } \
            if ((i) == 0) { if (t + 4 < SEQ / 64) ATT_DMA_K(t + 4, t & 3); } else if ((i) == 1) { if (t + 2 < SEQ / 64) ATT_DMA_V0(t + 2, s2); } else if ((i) == 2) { if (t + 2 < SEQ / 64) ATT_DMA_V1(t + 2, s2); } \
            sacc += P[4 * ((i) & 3)]; sacc += P[4 * ((i) & 3) + 1]; sacc += P[4 * ((i) & 3) + 2]; sacc += P[4 * ((i) & 3) + 3]; PIN(sacc); \
            if ((i) & 1) { pw[(i) >> 1].z = pkbf(P[4 * ((i) & 3)], P[4 * ((i) & 3) + 1]); pw[(i) >> 1].w = pkbf(P[4 * ((i) & 3) + 2], P[4 * ((i) & 3) + 3]); } \
            else { pw[(i) >> 1].x = pkbf(P[4 * ((i) & 3)], P[4 * ((i) & 3) + 1]); pw[(i) >> 1].y = pkbf(P[4 * ((i) & 3) + 2], P[4 * ((i) & 3) + 3]); } PIN(pw[(i) >> 1]); ATT_SB(); } while (0)
#define GB(j, C, HN) do { o[(j) & 3] = __builtin_amdgcn_mfma_f32_32x32x16_bf16(__builtin_bit_cast(abf16x8, pw[(j) >> 2]), VFR(j), o[(j) & 3], 0, 0, 0); if ((j) < 8) VRD((j) + 8); \
            if (HN) { C[(2 * (j)) & 15] = __builtin_amdgcn_exp2f(C[(2 * (j)) & 15] - MV); C[(2 * (j) + 1) & 15] = __builtin_amdgcn_exp2f(C[(2 * (j) + 1) & 15] - MV); PIN(C); } ATT_SB(); } while (0)
#define KPRE(s_) do { const LAS char* kp = shm + LDS_K + (s_) * KSLOT + krd; KRD(0); KRD(1); } while (0)
#define ATT_ITER(P0, P1, C0, C1, HN, WAITN, PRE) do { \
            asm volatile("s_waitcnt vmcnt(" #WAITN ")" ::: "memory"); ATT_BARK(); \
            const int s1 = slot == 2 ? 0 : slot + 1, s2 = slot >= 1 ? slot - 1 : 2; \
            const LAS char* kp = shm + LDS_K + ((t + 1) & 3) * KSLOT + krd; const LAS char* vp = shm + LDS_V + slot * VSLOT + vrd; \
            float sacc = 0.f; ATT_SB(); \
            GA(0, P0, C0, HN); GA(1, P0, C1, HN); GA(2, P0, C0, HN); GA(3, P0, C1, HN); GA(4, P1, C0, HN); GA(5, P1, C1, HN); GA(6, P1, C0, HN); GA(7, P1, C1, HN); \
            l_reg += sacc; \
            GB(0, C0, HN); GB(1, C0, HN); GB(2, C0, HN); GB(3, C0, HN); GB(4, C0, HN); GB(5, C0, HN); GB(6, C0, HN); GB(7, C0, HN); \
            GB(8, C1, HN); GB(9, C1, HN); GB(10, C1, HN); GB(11, C1, HN); GB(12, C1, HN); GB(13, C1, HN); GB(14, C1, HN); GB(15, C1, HN); \
            if (PRE) KPRE((t + 2) & 3); \
            slot = s1; ++t; } while (0)
        KPRE(1);
        int t = 0;
        if (!use_m) {
#define MV 0.f
            while (t < SEQ / 64 - 4) { ATT_ITER(pA0, pA1, pB0, pB1, true, 3, true); ATT_ITER(pB0, pB1, pA0, pA1, true, 3, true); }
            ATT_ITER(pA0, pA1, pB0, pB1, true, 3, true);
            ATT_ITER(pB0, pB1, pA0, pA1, true, 2, true);
            ATT_ITER(pA0, pA1, pB0, pB1, true, 2, false);
            ATT_ITER(pB0, pB1, pA0, pA1, false, 0, false);
#undef MV
        } else {
#define MV M
            while (t < SEQ / 64 - 4) { ATT_ITER(pA0, pA1, pB0, pB1, true, 3, true); ATT_ITER(pB0, pB1, pA0, pA1, true, 3, true); }
            ATT_ITER(pA0, pA1, pB0, pB1, true, 3, true);
            ATT_ITER(pB0, pB1, pA0, pA1, true, 2, true);
            ATT_ITER(pA0, pA1, pB0, pB1, true, 2, false);
            ATT_ITER(pB0, pB1, pA0, pA1, false, 0, false);
#undef MV
        }
#undef VRD
#undef VFR
#undef KRD
#undef KPRE
#undef PIN
#undef GA
#undef GB
#undef ATT_ITER
        ATT_BAR();
        {
            const int lane2 = lane_fresh(), r32b = lane2 & 31, hib = lane2 >> 5;
            LAS float* wsf = (LAS float*)(shm + LDS_WS) + wid * 128;
            l_reg += bperm_f(lane2 ^ 32, l_reg);
            if (hib == 0) wsf[r32b] = l_reg;
            asm volatile("s_waitcnt lgkmcnt(0)" ::: "memory");
            float rli[16];
#pragma unroll
            for (int r = 0; r < 16; ++r) rli[r] = __builtin_amdgcn_rcpf(wsf[crow(r, hib)]);
            const __amdgpu_buffer_rsrc_t trs = __builtin_amdgcn_make_buffer_rsrc((void*)(F.ws + WS_ATMP + ((size_t)((h * 32 + qb) * NWAVES + wid)) * 16384), 0, 16384, 0x00020000);
            const int toff = lane2 * 256;
            if (c == 0) {
#pragma unroll
                for (int d0 = 0; d0 < 4; ++d0)
#pragma unroll
                    for (int j = 0; j < 4; ++j) { v4u w; w.x = __float_as_uint(o[d0][4 * j] * rli[4 * j]); w.y = __float_as_uint(o[d0][4 * j + 1] * rli[4 * j + 1]); w.z = __float_as_uint(o[d0][4 * j + 2] * rli[4 * j + 2]); w.w = __float_as_uint(o[d0][4 * j + 3] * rli[4 * j + 3]);
                        __builtin_amdgcn_raw_buffer_store_b128(w, trs, toff + (d0 * 4 + j) * 16, 0, 0); }
                VM_WAIT();
            } else {
                const float lam = ((const float*)(F.ws + WS_SCAL))[l], li = lam_init_of(l);
                float ss[16];
#pragma unroll
                for (int r = 0; r < 16; ++r) ss[r] = 0.f;
#pragma unroll
                for (int d0 = 0; d0 < 4; ++d0)
#pragma unroll
                    for (int j = 0; j < 4; ++j) { const v4u w = __builtin_amdgcn_raw_buffer_load_b128(trs, toff + (d0 * 4 + j) * 16, 0, 0);
                        const float t0 = __uint_as_float(w.x), t1 = __uint_as_float(w.y), t2 = __uint_as_float(w.z), t3 = __uint_as_float(w.w);
                        float v;
                        v = t0 - lam * o[d0][4 * j] * rli[4 * j]; o[d0][4 * j] = v; ss[4 * j] += v * v;
                        v = t1 - lam * o[d0][4 * j + 1] * rli[4 * j + 1]; o[d0][4 * j + 1] = v; ss[4 * j + 1] += v * v;
                        v = t2 - lam * o[d0][4 * j + 2] * rli[4 * j + 2]; o[d0][4 * j + 2] = v; ss[4 * j + 2] += v * v;
                        v = t3 - lam * o[d0][4 * j + 3] * rli[4 * j + 3]; o[d0][4 * j + 3] = v; ss[4 * j + 3] += v * v; }
#pragma unroll
                for (int r = 0; r < 16; ++r) { float s = ss[r]; s += bperm_f(lane2 ^ 1, s); s += bperm_f(lane2 ^ 2, s); s += bperm_f(lane2 ^ 4, s); s += bperm_f(lane2 ^ 8, s); s += bperm_f(lane2 ^ 16, s);
                    ss[r] = rsqrtf(s * (1.f / 128.f) + EPS) * (1.f - li); }
                const float* sg = a.in[19] + (size_t)l * 128 + r32b;
                const __amdgpu_buffer_rsrc_t yrs = __builtin_amdgcn_make_buffer_rsrc((void*)((bf16*)(F.ws + WS_YA) + (size_t)q0 * DATT + h * 128), 0, 32 * DATT * 2, 0x00020000);
                const int yoff = r32b * 2 + hib * 4 * DATT * 2;
#pragma unroll
                for (int d0 = 0; d0 < 4; ++d0) { const float gg = sg[d0 * 32];
#pragma unroll
                    for (int r = 0; r < 16; ++r) __builtin_amdgcn_raw_buffer_store_b16((short)f2bf(o[d0][r] * ss[r] * gg), yrs, yoff + ((r & 3) + 8 * (r >> 2)) * DATT * 2 + d0 * 64, 0, 0); }
            }
        }
    }
#undef ATT_DMA_K
#undef ATT_DMA_V
#undef ATT_DMA_V0
#undef ATT_DMA_V1
#undef ATT_QK
#undef ATT_BAR
#undef ATT_BARK
#undef ATT_SB
}

enum { PH_P0 = 0, PH_L0 = 1, PH_PER_L = 12, PH_FINAL = PH_L0 + DEPTH * PH_PER_L, PH_COUNT = PH_FINAL + 1 };
enum { K_NORM1 = 0, K_INPROJ, K_QKNORM, K_ATTN, K_GLU, K_MERGE, K_OUT, K_NORM2, K_TOPK, K_GATHER, K_MOE1, K_MOE2 };

__global__ void __launch_bounds__(NWAVES * 64, 2) mk_fwd(Args args) {
    extern __shared__ __attribute__((aligned(16))) unsigned char lds[];
    Frame F;
    F.lds = (LAS unsigned char*)lds;
    F.MISC = (volatile LAS unsigned*)(F.lds + MISC_OFF);
    F.wave = __builtin_amdgcn_readfirstlane((int)threadIdx.x >> 6);
    F.G = gridDim.x; { const int bx = blockIdx.x; F.vcu = (F.G % 8 == 0) ? (bx % 8) * (F.G / 8) + bx / 8 : bx; }
    F.ws = (GAS unsigned char*)args.ws; F.ctl = (gu32*)(F.ws + WS_CTL); F.out = (GAS float*)args.out;
    for (int u = (int)threadIdx.x; u < (LDS_BYTES - LDSCTL_OFF) / 4; u += NWAVES * 64) ((LAS unsigned*)(F.lds + LDSCTL_OFF))[u] = 0u;
    __syncthreads();
    XcdBarrier bar = xcd_barrier_post((unsigned*)(F.ctl + CW_BAR) + args.bar_idx * XCD_BAR_WORDS, F.MISC + 8, F.wave == 0 ? 1u : 0u);
#define FRESH() do { GAS unsigned char* w_ = (GAS unsigned char*)args.ws; GAS float* o_ = (GAS float*)args.out; asm volatile("" : "+s"(w_), "+s"(o_)); F.ws = w_; F.ctl = (gu32*)(w_ + WS_CTL); F.out = o_; } while (0)
#define HN ((bf16*)(F.ws + WS_HN))
#define XB ((float*)(F.ws + WS_XB))
#define XA ((float*)F.out)
#define YE ((bf16*)(F.ws + WS_YE))
#define SEL ((int*)(F.ws + WS_SEL))
#define IDX ((int*)(F.ws + WS_IDX))
#define GW ((float*)(F.ws + WS_GW))
#define AFF ((float*)(F.ws + WS_AFF))
    const int lo = args.ph_lo, hi = args.ph_hi;
#define IN(k) (lo <= (k) && (k) < hi)
#define SEAM(k) do { if (IN(k) && IN((k) + 1)) xcd_barrier(bar); } while (0)

    if (IN(PH_P0)) { FRESH(); p0_prologue(F, args); FRESH(); phase_norm_rows(F, args.in[0], nullptr, nullptr, nullptr, args.in[1], HN, (unsigned char*)(F.ws + WS_H8)); SEAM(PH_P0); }

#pragma nounroll
    for (int l = 0; l < DEPTH; ++l) {
        const int pb = PH_L0 + l * PH_PER_L;
        if (IN(pb + K_NORM1)) {
            FRESH();
            if (l > 0) { phase_norm_rows(F, XA, XB, YE, SEL, args.in[1] + (size_t)l * DM, HN, (unsigned char*)(F.ws + WS_H8)); SEAM(pb + K_NORM1); }
        }
        if (IN(pb + K_INPROJ)) {
            FRESH();
            { pg8::Gemm g{HN, (const bf16*)(F.ws + WS_WIN) + (size_t)l * INC * DM, SEQ, 4096, DM}; pg8::StaticOrder S; S.init(SEQ, 4096, F.G, (int)blockIdx.x);
              pg8::EpiInProj E{(bf16*)(F.ws + WS_U), (bf16*)(F.ws + WS_QRAW), (bf16*)(F.ws + WS_KRAW), (bf16*)(F.ws + WS_V), (bf16*)(F.ws + WS_GATE), args.in[3] + (size_t)l * 2 * DM};
              pg8::gemm_phase<pg8::EpiInProj, pg8::StaticOrder, PG8_ALIGN, PG8_SP2>(F.lds + RING_OFF, g, S, E, F.wave); }
            VM_WAIT(); __syncthreads();
            { pg8::Gemm g{(const bf16*)(F.ws + WS_H8), (const bf16*)(F.ws + WS_WIN + (size_t)l * INC * DM * 2 + WIN8_OFF), SEQ, 4096, DM / 2}; pg8::StaticOrder S; S.init(SEQ, 4096, F.G, (int)blockIdx.x);
              pg8::EpiGateF8 E{(bf16*)(F.ws + WS_GATE), args.in[3] + (size_t)l * 2 * DM};
              pg8::gemm_phase<pg8::EpiGateF8, pg8::StaticOrder, false, PG8_SP2, true>(F.lds + RING_OFF, g, S, E, F.wave); }
            SEAM(pb + K_INPROJ);
        }
        if (IN(pb + K_QKNORM)) {
            FRESH();
            auto prefetch_e = [&]() { const int u = fresh_s(F.vcu); if (u < NG * 4) { const int g = u >> 2, part = u & 3, ln = lane_fresh();
                const GAS unsigned char* em_ = F.ws + WS_EMAT + (size_t)(l * NG + g) * 131072; const GAS unsigned char* ub_ = F.ws + WS_U + ((size_t)g * SEQ + 2048 * part) * 32;
                const unsigned dl = (unsigned)__builtin_amdgcn_readfirstlane((int)((unsigned)(uintptr_t)F.lds + 135168u));
                att::glds16s<0>((const void*)(em_ + (size_t)(F.wave * 128) * 128), (unsigned)ln * 128u, dl);
                att::glds16s<0>((const void*)(em_ + (size_t)(F.wave * 128 + 64) * 128), (unsigned)ln * 128u, dl);
                att::glds16s<0>((const void*)(ub_ + (size_t)(F.wave * 64) * 128), (unsigned)ln * 128u, dl); } };
            phase_qknorm(F, l, args.in[13] + l * HD, args.in[14] + l * HD, prefetch_e);
#if USE_FAST_SSM
            for (int u = fresh_s(F.vcu); u < NG * 4; u += F.G) ssm_e_unit(F, l, u >> 2, u & 3);
#endif
            SEAM(pb + K_QKNORM);
        }
        if (IN(pb + K_ATTN)) {
#if USE_FAST_ATTN
            for (int u = fresh_s(F.vcu); u < NHEAD * 32; u += F.G) attn_unit(F, args, l, u >> 5, u & 31);
#endif
#if USE_FAST_SSM
            for (int u = fresh_s(F.vcu); u < NG * 4; u += F.G) ssm_y_unit(F, l, u >> 2, u & 3);
#endif
            SEAM(pb + K_ATTN);
        }
        if (IN(pb + K_GLU)) {
            FRESH();
            { const int eend = l == 0 ? P0_END_GLU0 : P0_END_GLU1, it1 = P0_I_TOTAL - eend * P0_I_PER_E, it0 = it1 - P0_DEF_GLU * P0_I_PER_E;
              constexpr int NT_GLU = (SEQ / 256) * (DSSM / 256);
              if (F.G > NT_GLU) { const int b = fresh_s((int)blockIdx.x); if (b >= NT_GLU) convert_items<false>(F, args, it0, it1, (b - NT_GLU) * NWAVES + F.wave, (F.G - NT_GLU) * NWAVES); }
              else convert_items<false>(F, args, it0, it1, fresh_s(F.vcu * NWAVES + F.wave), F.G * NWAVES); }
            FRESH();
            pg8::Gemm g{(const bf16*)(F.ws + WS_YS), (const bf16*)(F.ws + WS_WGLU) + (size_t)l * DSSM * DSSM, SEQ, DSSM, DSSM}; pg8::StaticOrder S; S.init(SEQ, DSSM, F.G, (int)blockIdx.x);
            pg8::EpiGlu E{(const bf16*)(F.ws + WS_YS), (bf16*)(F.ws + WS_YS2)};
            pg8::gemm_phase<pg8::EpiGlu, pg8::StaticOrder, PG8_ALIGN, PG8_SP2>(F.lds + RING_OFF, g, S, E, F.wave);
            SEAM(pb + K_GLU);
        }
        if (IN(pb + K_MERGE)) {
            FRESH();
            { pg8::Gemm g{(const bf16*)(F.ws + WS_YS2), (const bf16*)(F.ws + WS_WBS) + (size_t)l * DM * DSSM, SEQ, DM, DSSM}; pg8::StaticOrder S; S.init(SEQ, DM, F.G, (int)blockIdx.x);
              pg8::EpiMerge<true> E{(const bf16*)(F.ws + WS_GATE), (bf16*)(F.ws + WS_MERGED)};
              pg8::gemm_phase<pg8::EpiMerge<true>, pg8::StaticOrder, PG8_ALIGN, PG8_SP2>(F.lds + RING_OFF, g, S, E, F.wave); }
            VM_WAIT(); __syncthreads();
            { pg8::Gemm g{(const bf16*)(F.ws + WS_YA), (const bf16*)(F.ws + WS_WBA) + (size_t)l * DM * DATT, SEQ, DM, DATT}; pg8::StaticOrder S; S.init(SEQ, DM, F.G, (int)blockIdx.x);
              pg8::EpiMerge<false> E{(const bf16*)(F.ws + WS_GATE), (bf16*)(F.ws + WS_MERGED)};
              pg8::gemm_phase<pg8::EpiMerge<false>, pg8::StaticOrder, PG8_ALIGN, PG8_SP2>(F.lds + RING_OFF, g, S, E, F.wave); }
            SEAM(pb + K_MERGE);
        }
        if (IN(pb + K_OUT)) {
            FRESH();
            pg8::Gemm g{(const bf16*)(F.ws + WS_MERGED), (const bf16*)(F.ws + WS_WOUT) + (size_t)l * DM * DM, SEQ, DM, DM}; pg8::StaticOrder S; S.init(SEQ, DM, F.G, (int)blockIdx.x);
            pg8::EpiOutRes E{l == 0 ? args.in[0] : (const float*)XB, XA};
            pg8::gemm_phase<pg8::EpiOutRes, pg8::StaticOrder, PG8_ALIGN, PG8_SP2>(F.lds + RING_OFF, g, S, E, F.wave);
            SEAM(pb + K_OUT);
        }
        if (IN(pb + K_NORM2)) {
            FRESH();
            phase_norm_router(F, XA, args.in[23] + (size_t)l * DM, (const float*)(F.ws + WS_WRT) + (size_t)l * NE * DM, HN, AFF);
            SEAM(pb + K_NORM2);
        }
        if (IN(pb + K_TOPK)) { FRESH();
            { const int eend = l == 0 ? P0_END_TOPK0 : P0_END_TOPK1, it1 = P0_I_TOTAL - eend * P0_I_PER_E, it0 = it1 - P0_DEF_TOPK * P0_I_PER_E;
              if (F.G > NE) { const int v = fresh_s(F.vcu); if (v >= NE) convert_items<false>(F, args, it0, it1, (v - NE) * NWAVES + F.wave, (F.G - NE) * NWAVES); }
              else convert_items<false>(F, args, it0, it1, fresh_s(F.vcu * NWAVES + F.wave), F.G * NWAVES); }
            FRESH(); phase_topk(F, AFF, SEL, IDX, GW); SEAM(pb + K_TOPK); }
        if (IN(pb + K_GATHER)) { FRESH(); phase_gather8(F, (const unsigned char*)HN, IDX, (unsigned char*)(F.ws + WS_XE)); SEAM(pb + K_GATHER); }
        if (IN(pb + K_MOE1)) {
            FRESH();
            pg8::Gemm g{(const bf16*)(F.ws + WS_XE), (const bf16*)(F.ws + WS_WGU + (size_t)l * NE * 2048 * 2048), NE * CAP, 2048, DM / 2}; pg8::GroupedOrder S; S.init(8, F.G, F.vcu);
            pg8::EpiMoe1F8 E{(unsigned char*)(F.ws + WS_HE)};
            pg8::gemm_phase<pg8::EpiMoe1F8, pg8::GroupedOrder, PG8_ALIGN, PG8_SP2, true>(F.lds + RING_OFF, g, S, E, F.wave);
            SEAM(pb + K_MOE1);
        }
        if (IN(pb + K_MOE2)) {
            FRESH();
            pg8::Gemm g{(const bf16*)(F.ws + WS_HE), (const bf16*)(F.ws + WS_WD + (size_t)l * NE * 2048 * 1024), NE * CAP, DM, DE / 2}; pg8::GroupedOrder S; S.init(8, F.G, F.vcu);
            pg8::EpiMoe2F8 E{YE, GW};
            pg8::gemm_phase<pg8::EpiMoe2F8, pg8::GroupedOrder, PG8_ALIGN, PG8_SP2, true>(F.lds + RING_OFF, g, S, E, F.wave);
            SEAM(pb + K_MOE2);
        }
    }
    if (IN(PH_FINAL)) { FRESH(); }
    if (IN(PH_FINAL)) phase_norm_rows(F, XA, XA, YE, SEL, nullptr, nullptr);
#undef IN
#undef SEAM
#undef FRESH
#undef HN
#undef XB
#undef XA
#undef YE
#undef SEL
#undef IDX
#undef GW
#undef AFF
}


#ifndef DBG_STOP
#define DBG_STOP 0
#endif
#if DBG_STOP
__global__ void dbg_fold(float* out, unsigned char* ws, int stage) {
    const size_t n = (size_t)SEQ * DM;
    for (size_t i = (size_t)blockIdx.x * blockDim.x + threadIdx.x; i < n; i += (size_t)gridDim.x * blockDim.x) {
        float v = 0.f; const size_t h = i & ((size_t)SEQ * 1024 - 1);
        if (stage == 1) { v = bf2f(((const bf16*)(ws + WS_GATE))[i]) + bf2f(((const bf16*)(ws + WS_GATE))[i + n]) + bf2f(((const bf16*)(ws + WS_U))[h]) + bf2f(((const bf16*)(ws + WS_V))[h]) + bf2f(((const bf16*)(ws + WS_QRAW))[h]) + bf2f(((const bf16*)(ws + WS_KRAW))[h]); }
        if (stage == 2) { v = bf2f(((const bf16*)(ws + WS_QN))[h]) + bf2f(((const bf16*)(ws + WS_KN))[h]) + bf2f(((const bf16*)(ws + WS_YS))[h]) + bf2f(((const bf16*)(ws + WS_YA))[h]); }
        if (stage == 3) { v = out[i] + bf2f(((const bf16*)(ws + WS_YS2))[h]) + bf2f(((const bf16*)(ws + WS_MERGED))[i]); }
        if (stage == 4) { v = bf2f(((const bf16*)(ws + WS_HN))[i]) + ((const float*)(ws + WS_AFF))[i & (SEQ * 16 - 1)] + (float)((const int*)(ws + WS_IDX))[i & 16383] + ((const float*)(ws + WS_GW))[i & 16383] + bf2f(((const bf16*)(ws + WS_HE))[i]) + bf2f(((const bf16*)(ws + WS_YE))[i]) + bf2f(((const bf16*)(ws + WS_YE))[i + n]); }
        out[i] = v;
    }
}
#endif

extern "C" void kernel_launch(void* const* d_in, const int* in_sizes, int n_in, void* d_out, int out_size, void* d_ws, size_t ws_size, hipStream_t stream) {
    static int grid = 0;
    if (grid == 0) {
        if (n_in != 28 || in_sizes[0] != SEQ * DM || out_size != SEQ * DM || ws_size < WS_END) { fprintf(stderr, "kernel_launch: unexpected problem shape / workspace (%d inputs, ws %zu)\n", n_in, ws_size); grid = -1; return; }
        int dev = 0, cus = 0;
        if (hipGetDevice(&dev) != hipSuccess || hipDeviceGetAttribute(&cus, hipDeviceAttributeMultiprocessorCount, dev) != hipSuccess) { grid = -1; return; }
        if (hipFuncSetAttribute((const void*)mk_fwd, hipFuncAttributeMaxDynamicSharedMemorySize, LDS_BYTES) != hipSuccess) { fprintf(stderr, "kernel_launch: hipFuncSetAttribute failed\n"); grid = -1; return; }
        int per_cu = 0;
        if (hipOccupancyMaxActiveBlocksPerMultiprocessor(&per_cu, (const void*)mk_fwd, NWAVES * 64, LDS_BYTES) != hipSuccess || per_cu < 1) fprintf(stderr, "kernel_launch: occupancy query says %d\n", per_cu);
        (void)hipGetLastError();
        grid = cus;
    }
    if (grid < 0) return;
    (void)hipMemsetAsync((char*)d_ws + WS_CTL, 0, CTL_ZERO_BYTES, stream);
    Args a{};
    for (int i = 0; i < 28; ++i) a.in[i] = (const float*)d_in[i];
    a.out = (float*)d_out; a.ws = (unsigned char*)d_ws;
    int nl = 0;
    auto run = [&](int lo, int hi) { a.ph_lo = lo; a.ph_hi = hi; a.bar_idx = nl++; a.pad = 0; hipLaunchKernelGGL(mk_fwd, dim3(grid), dim3(NWAVES * 64), LDS_BYTES, stream, a); };
    unsigned char* ws = (unsigned char*)d_ws;
#ifndef MK_PER_PHASE
#define MK_PER_PHASE 0
#endif
#if !MK_PER_PHASE
    run(PH_P0, PH_COUNT);
#else
    run(PH_P0, PH_P0 + 1);
    for (int l = 0; l < DEPTH; ++l) {
        const int pb = PH_L0 + l * PH_PER_L;
        run(pb + K_NORM1, pb + K_NORM1 + 1); run(pb + K_INPROJ, pb + K_INPROJ + 1);
#if DBG_STOP == 1
        hipLaunchKernelGGL(dbg_fold, dim3(2048), dim3(256), 0, stream, (float*)d_out, ws, 1); return;
#endif
        run(pb + K_QKNORM, pb + K_QKNORM + 1);
        run(pb + K_ATTN, pb + K_ATTN + 1);
#if DBG_STOP == 2
        hipLaunchKernelGGL(dbg_fold, dim3(2048), dim3(256), 0, stream, (float*)d_out, ws, 2); return;
#endif
        for (int k = K_GLU; k <= K_OUT; ++k) run(pb + k, pb + k + 1);
#if DBG_STOP == 3
        hipLaunchKernelGGL(dbg_fold, dim3(2048), dim3(256), 0, stream, (float*)d_out, ws, 3); return;
#endif
        for (int k = K_NORM2; k <= K_MOE2; ++k) run(pb + k, pb + k + 1);
#if DBG_STOP == 4
        hipLaunchKernelGGL(dbg_fold, dim3(2048), dim3(256), 0, stream, (float*)d_out, ws, 4); return;
#endif
    }
    run(PH_FINAL, PH_FINAL + 1);
#endif
}
```

```cpp
#include <hip/hip_runtime.h>
#include <cstdio>
#include <cstdint>
__device__ __forceinline__ int lane_id_asm() { int x; asm volatile("v_mbcnt_lo_u32_b32 %0, -1, 0\n\tv_mbcnt_hi_u32_b32 %0, -1, %0" : "=v"(x)); return x; }
namespace pg8 {
#define PG8_LAS __attribute__((address_space(3)))
typedef unsigned short bf16_t;
typedef short bf16x8 __attribute__((ext_vector_type(8)));
typedef float f32x4 __attribute__((ext_vector_type(4)));
typedef unsigned u32x4 __attribute__((ext_vector_type(4)));
constexpr int BM = 256, BK = 64, HALF = 128, HTB = HALF * BK * 2  , STAGE_BYTES = 8 * HTB, NXCD = 8, WGM = 8;

__host__ __device__ __forceinline__ int lds_byte(int r, int c) { const int st = (r >> 4) * 2 + (c >> 5), rr = r & 15, cc = c & 31, ob = rr * 64 + cc * 2; return st * 1024 + (ob ^ (((ob >> 9) & 1) << 5)); }
__host__ __device__ __forceinline__ void stage_rc(int b, int& R, int& C) { const int st = b / 1024, sb = b % 1024, swz = sb ^ (((sb >> 9) & 1) << 5); R = (st >> 1) * 16 + swz / 64; C = (st & 1) * 32 + (swz % 64) / 2; }
__host__ __device__ __forceinline__ int perm32(int rho) { const int n = rho >> 4, i = rho & 15; return 8 * (i >> 2) + 4 * n + (i & 3); }

struct Unit { int pm, pn, pb; };
struct Gemm { const bf16_t* A; const bf16_t* Bt; int M, N, K; };

struct StaticOrder {
    int nM, nN, nwg, G, c;
    __host__ __device__ void init(int M, int N, int G_, int c_) { nM = M / BM; nN = N / BM; nwg = nM * nN; G = G_; c = c_; }
    __host__ __device__ bool next(int i, Unit& u) const {
        const long L = (long)i * G + c; if (L >= nwg) return false;
        int wgid = (int)L; { const int q = nwg / NXCD, r = nwg % NXCD, xcd = wgid % NXCD, off = wgid / NXCD; wgid = (xcd < r ? xcd * (q + 1) : r * (q + 1) + (xcd - r) * q) + off; }
        const int nig = WGM * nN, gid = wgid / nig, fm = gid * WGM, gsz = (nM - fm) < WGM ? (nM - fm) : WGM;
        u.pm = fm + ((wgid % nig) % gsz); u.pn = (wgid % nig) / gsz; u.pb = u.pn; return true;
    }
    __device__ __forceinline__ void a_ready(const Unit&) const {}
    __device__ __forceinline__ void done(const Unit&) const {}
};


typedef float f32x2_t __attribute__((ext_vector_type(2))); typedef __bf16 bf16x2_t __attribute__((ext_vector_type(2)));
__device__ __forceinline__ unsigned cvt_pk_bf16(float lo, float hi) { f32x2_t v = {lo, hi}; bf16x2_t b = __builtin_convertvector(v, bf16x2_t); return __builtin_bit_cast(unsigned, b); }
__device__ __forceinline__ float bflo(unsigned w) { return __uint_as_float(w << 16); }
__device__ __forceinline__ float bfhi(unsigned w) { return __uint_as_float(w & 0xffff0000u); }
__device__ __forceinline__ float sigm(float x) { return __builtin_amdgcn_rcpf(1.f + __builtin_amdgcn_exp2f(-1.4426950408889634f * x)); }
__device__ __forceinline__ u32x4 pack8(const f32x4& v0, const f32x4& v1) { u32x4 w; w.x = cvt_pk_bf16(v0[0], v0[1]); w.y = cvt_pk_bf16(v0[2], v0[3]); w.z = cvt_pk_bf16(v1[0], v1[1]); w.w = cvt_pk_bf16(v1[2], v1[3]); return w; }

struct EpiInProj {
    static constexpr bool PERM = true, AFTER_DRAIN = false;
    bf16_t *U, *Q, *Kk, *V, *G; const float* gate_b;
    __device__ __forceinline__ void operator()(const f32x4 (&acc)[2][2][4][2], const Unit& u, int wr, int wc, int fr, int fq) const {
        const int row0 = u.pm * BM + wr * 64 + fr, ct = u.pn * BM, lc = wc * 32 + 8 * fq;
        if (ct < 1024) {
            const int c0 = ct + lc;
            bf16_t* gb0 = U + ((size_t)(c0 >> 4) * 8192) * 16 + (c0 & 15); bf16_t* gb1 = U + ((size_t)((c0 + HALF) >> 4) * 8192) * 16 + (c0 & 15);
#pragma unroll
            for (int ai = 0; ai < 2; ++ai)
#pragma unroll
                for (int m = 0; m < 4; ++m) { const size_t ro = (size_t)(row0 + ai * HALF + m * 16) * 16;
                    *(u32x4*)(gb0 + ro) = pack8(acc[ai][0][m][0], acc[ai][0][m][1]); *(u32x4*)(gb1 + ro) = pack8(acc[ai][1][m][0], acc[ai][1][m][1]); }
        } else if (ct < 4096) {
            bf16_t* base = Q + (size_t)((ct >> 10) - 1) * (8u << 20);
            const int c0 = (ct & 1023) + lc;
#pragma unroll
            for (int ai = 0; ai < 2; ++ai)
#pragma unroll
                for (int m = 0; m < 4; ++m) { bf16_t* rowp = base + (size_t)(row0 + ai * HALF + m * 16) * 1024 + c0;
#pragma unroll
                    for (int bj = 0; bj < 2; ++bj) *(u32x4*)(rowp + bj * HALF) = pack8(acc[ai][bj][m][0], acc[ai][bj][m][1]); }
        } else {
            const int c0 = ct - 4096 + lc;
            f32x4 bv[2][2];
#pragma unroll
            for (int bj = 0; bj < 2; ++bj)
#pragma unroll
                for (int n = 0; n < 2; ++n) bv[bj][n] = *(const f32x4*)(gate_b + c0 + bj * HALF + 4 * n);
#pragma unroll
            for (int ai = 0; ai < 2; ++ai)
#pragma unroll
                for (int m = 0; m < 4; ++m) { bf16_t* rowp = G + (size_t)(row0 + ai * HALF + m * 16) * 4096 + c0;
#pragma unroll
                    for (int bj = 0; bj < 2; ++bj) { f32x4 v0 = acc[ai][bj][m][0] + bv[bj][0], v1 = acc[ai][bj][m][1] + bv[bj][1];
#pragma unroll
                        for (int j = 0; j < 4; ++j) { v0[j] = sigm(v0[j]); v1[j] = sigm(v1[j]); }
                        *(u32x4*)(rowp + bj * HALF) = pack8(v0, v1); } }
        }
    }
};
struct EpiGlu {
    static constexpr bool PERM = true, AFTER_DRAIN = false;
    const bf16_t* YS; bf16_t* O;
    __device__ __forceinline__ void operator()(const f32x4 (&acc)[2][2][4][2], const Unit& u, int wr, int wc, int fr, int fq) const {
        const int row0 = u.pm * BM + wr * 64 + fr, c0 = u.pn * BM + wc * 32 + 8 * fq;
#pragma unroll
        for (int ai = 0; ai < 2; ++ai)
#pragma unroll
            for (int m = 0; m < 4; ++m) { const size_t ro = (size_t)(row0 + ai * HALF + m * 16) * 1024 + c0;
#pragma unroll
                for (int bj = 0; bj < 2; ++bj) { const u32x4 y = *(const u32x4*)(YS + ro + bj * HALF); f32x4 v0 = acc[ai][bj][m][0], v1 = acc[ai][bj][m][1];
                    v0[0] = bflo(y.x) * sigm(v0[0]); v0[1] = bfhi(y.x) * sigm(v0[1]); v0[2] = bflo(y.y) * sigm(v0[2]); v0[3] = bfhi(y.y) * sigm(v0[3]);
                    v1[0] = bflo(y.z) * sigm(v1[0]); v1[1] = bfhi(y.z) * sigm(v1[1]); v1[2] = bflo(y.w) * sigm(v1[2]); v1[3] = bfhi(y.w) * sigm(v1[3]);
                    *(u32x4*)(O + ro + bj * HALF) = pack8(v0, v1); } }
    }
};
template <bool FIRST> struct EpiMerge {
    static constexpr bool PERM = true, AFTER_DRAIN = false;
    const bf16_t* G; bf16_t* O;
    __device__ __forceinline__ void operator()(const f32x4 (&acc)[2][2][4][2], const Unit& u, int wr, int wc, int fr, int fq) const {
        const int row0 = u.pm * BM + wr * 64 + fr, c0 = u.pn * BM + wc * 32 + 8 * fq;
#pragma unroll
        for (int ai = 0; ai < 2; ++ai)
#pragma unroll
            for (int m = 0; m < 4; ++m) { const int row = row0 + ai * HALF + m * 16;
#pragma unroll
                for (int bj = 0; bj < 2; ++bj) { const u32x4 g = *(const u32x4*)(G + (size_t)row * 4096 + (FIRST ? 0 : 2048) + c0 + bj * HALF); f32x4 v0 = acc[ai][bj][m][0], v1 = acc[ai][bj][m][1];
                    bf16_t* op = O + (size_t)row * 2048 + c0 + bj * HALF;
                    v0[0] *= bflo(g.x); v0[1] *= bfhi(g.x); v0[2] *= bflo(g.y); v0[3] *= bfhi(g.y); v1[0] *= bflo(g.z); v1[1] *= bfhi(g.z); v1[2] *= bflo(g.w); v1[3] *= bfhi(g.w);
                    if (!FIRST) { const u32x4 o = *(const u32x4*)op;
                        v0[0] += bflo(o.x); v0[1] += bfhi(o.x); v0[2] += bflo(o.y); v0[3] += bfhi(o.y); v1[0] += bflo(o.z); v1[1] += bfhi(o.z); v1[2] += bflo(o.w); v1[3] += bfhi(o.w); }
                    *(u32x4*)op = pack8(v0, v1); } }
    }
};
struct EpiOutRes {
    static constexpr bool PERM = false, AFTER_DRAIN = false;
    const float* R; float* C;
    __device__ __forceinline__ void operator()(const f32x4 (&acc)[2][2][4][2], const Unit& u, int wr, int wc, int fr, int fq) const {
        const int row0 = u.pm * BM + wr * 64 + fr, col0 = u.pn * BM + wc * 32 + 4 * fq;
#pragma unroll
        for (int ai = 0; ai < 2; ++ai)
#pragma unroll
            for (int m = 0; m < 4; ++m) { const size_t ro = (size_t)(row0 + ai * HALF + m * 16) * 2048 + col0;
#pragma unroll
                for (int bj = 0; bj < 2; ++bj)
#pragma unroll
                    for (int n = 0; n < 2; ++n) *(f32x4*)(C + ro + bj * HALF + n * 16) = acc[ai][bj][m][n] + *(const f32x4*)(R + ro + bj * HALF + n * 16); }
    }
};
struct EpiMoe1 {
    static constexpr bool PERM = true, AFTER_DRAIN = false;
    bf16_t* H;
    __device__ __forceinline__ void operator()(const f32x4 (&acc)[2][2][4][2], const Unit& u, int wr, int wc, int fr, int fq) const {
        const int row0 = u.pm * BM + wr * 64 + fr, c0 = u.pn * HALF + wc * 32 + 8 * fq;
#pragma unroll
        for (int ai = 0; ai < 2; ++ai)
#pragma unroll
            for (int m = 0; m < 4; ++m) { f32x4 v[2];
#pragma unroll
                for (int n = 0; n < 2; ++n)
#pragma unroll
                    for (int j = 0; j < 4; ++j) { const float g = acc[ai][0][m][n][j]; v[n][j] = g * sigm(g) * acc[ai][1][m][n][j]; }
                *(u32x4*)(H + (size_t)(row0 + ai * HALF + m * 16) * 1024 + c0) = pack8(v[0], v[1]); }
    }
};
struct EpiMoe2 {
    static constexpr bool PERM = true, AFTER_DRAIN = false;
    bf16_t* Y; const float* gw;
    __device__ __forceinline__ void operator()(const f32x4 (&acc)[2][2][4][2], const Unit& u, int wr, int wc, int fr, int fq) const {
        const int row0 = u.pm * BM + wr * 64 + fr, c0 = u.pn * BM + wc * 32 + 8 * fq;
#pragma unroll
        for (int ai = 0; ai < 2; ++ai)
#pragma unroll
            for (int m = 0; m < 4; ++m) { const int row = row0 + ai * HALF + m * 16; const float s = gw[row];
#pragma unroll
                for (int bj = 0; bj < 2; ++bj) *(u32x4*)(Y + (size_t)row * 2048 + c0 + bj * HALF) = pack8(acc[ai][bj][m][0] * s, acc[ai][bj][m][1] * s); }
    }
};

__device__ __forceinline__ float clamp448(float v) { return __builtin_fminf(__builtin_fmaxf(v, -448.f), 448.f); }
__device__ __forceinline__ unsigned pack4_fp8(float a, float b, float c, float d) { int w = 0; w = __builtin_amdgcn_cvt_pk_fp8_f32(clamp448(a), clamp448(b), w, false); w = __builtin_amdgcn_cvt_pk_fp8_f32(clamp448(c), clamp448(d), w, true); return (unsigned)w; }
constexpr float F8_WSCALE = 64.f, F8_HSCALE = 4.f;
struct EpiGateF8 {
    static constexpr bool PERM = true, AFTER_DRAIN = false;
    bf16_t* G; const float* gate_b;
    __device__ __forceinline__ void operator()(const f32x4 (&acc)[2][2][4][2], const Unit& u, int wr, int wc, int fr, int fq) const {
        const int row0 = u.pm * BM + wr * 64 + fr, c0 = u.pn * BM + wc * 32 + 8 * fq;
        f32x4 bv[2][2];
#pragma unroll
        for (int bj = 0; bj < 2; ++bj)
#pragma unroll
            for (int n = 0; n < 2; ++n) bv[bj][n] = *(const f32x4*)(gate_b + c0 + bj * HALF + 4 * n);
#pragma unroll
        for (int ai = 0; ai < 2; ++ai)
#pragma unroll
            for (int m = 0; m < 4; ++m) { bf16_t* rowp = G + (size_t)(row0 + ai * HALF + m * 16) * 4096 + c0;
#pragma unroll
                for (int bj = 0; bj < 2; ++bj) { f32x4 v0 = acc[ai][bj][m][0] * (1.f / F8_WSCALE) + bv[bj][0], v1 = acc[ai][bj][m][1] * (1.f / F8_WSCALE) + bv[bj][1];
#pragma unroll
                    for (int j = 0; j < 4; ++j) { v0[j] = sigm(v0[j]); v1[j] = sigm(v1[j]); }
                    *(u32x4*)(rowp + bj * HALF) = pack8(v0, v1); } }
    }
};
struct EpiMoe1F8 {
    static constexpr bool PERM = true, AFTER_DRAIN = false;
    unsigned char* H;
    __device__ __forceinline__ void operator()(const f32x4 (&acc)[2][2][4][2], const Unit& u, int wr, int wc, int fr, int fq) const {
        const int row0 = u.pm * BM + wr * 64 + fr, c0 = u.pn * HALF + wc * 32 + 8 * fq;
#pragma unroll
        for (int ai = 0; ai < 2; ++ai)
#pragma unroll
            for (int m = 0; m < 4; ++m) { f32x4 v[2];
#pragma unroll
                for (int n = 0; n < 2; ++n)
#pragma unroll
                    for (int j = 0; j < 4; ++j) { const float g = acc[ai][0][m][n][j] * (1.f / F8_WSCALE); v[n][j] = g * sigm(g) * acc[ai][1][m][n][j] * (F8_HSCALE / F8_WSCALE); }
                typedef unsigned u32x2_ __attribute__((ext_vector_type(2)));
                u32x2_ w; w.x = pack4_fp8(v[0][0], v[0][1], v[0][2], v[0][3]); w.y = pack4_fp8(v[1][0], v[1][1], v[1][2], v[1][3]);
                *(u32x2_*)(H + (size_t)(row0 + ai * HALF + m * 16) * 1024 + c0) = w; }
    }
};
struct EpiMoe2F8 {
    static constexpr bool PERM = true, AFTER_DRAIN = false;
    bf16_t* Y; const float* gw;
    __device__ __forceinline__ void operator()(const f32x4 (&acc)[2][2][4][2], const Unit& u, int wr, int wc, int fr, int fq) const {
        const int row0 = u.pm * BM + wr * 64 + fr, c0 = u.pn * BM + wc * 32 + 8 * fq;
#pragma unroll
        for (int ai = 0; ai < 2; ++ai)
#pragma unroll
            for (int m = 0; m < 4; ++m) { const int row = row0 + ai * HALF + m * 16; const float s = gw[row] * (1.f / (F8_WSCALE * F8_HSCALE));
#pragma unroll
                for (int bj = 0; bj < 2; ++bj) *(u32x4*)(Y + (size_t)row * 2048 + c0 + bj * HALF) = pack8(acc[ai][bj][m][0] * s, acc[ai][bj][m][1] * s); }
    }
};
struct GroupedOrder {
    int nN, G, v, total;
    __host__ __device__ void init(int nN_, int G_, int v_) { nN = nN_; G = G_; v = v_; total = 16 * 4 * nN_; }
    __host__ __device__ bool next(int i, Unit& u) const {
        const int id = i * G + v; if (id >= total) return false;
        const int per = 4 * nN, e = id / per, r = id % per; u.pm = e * 4 + (r & 3); u.pn = r >> 2; u.pb = e * nN + u.pn; return true;
    }
    __device__ __forceinline__ void a_ready(const Unit&) const {}
    __device__ __forceinline__ void done(const Unit&) const {}
};

typedef int i32x8 __attribute__((ext_vector_type(8)));
typedef int i32x4 __attribute__((ext_vector_type(4)));
__device__ __forceinline__ i32x8 cat8(bf16x8 lo, bf16x8 hi) { const i32x4 a = __builtin_bit_cast(i32x4, lo), b = __builtin_bit_cast(i32x4, hi); return __builtin_shufflevector(a, b, 0, 1, 2, 3, 4, 5, 6, 7); }
template <class Epi, class Sched, bool ALIGN_EPI = false, bool SP2 = false, bool FP8 = false>
__device__ __forceinline__ void gemm_phase(PG8_LAS unsigned char* lds, const Gemm g, const Sched& S, const Epi& E, const int wave) {
    int lane_ = lane_id_asm();
    const int wid = wave, lane = lane_, tid = wid * 64 + lane, wr = wid >> 2, wc = wid & 3, fr = lane & 15, fq = lane >> 4;
    const int K = g.K, nt = K / BK;
    unsigned voffA[2], voffB[2];
#pragma unroll
    for (int i = 0; i < 2; ++i) { int R, C; stage_rc(tid * 16 + i * 8192, R, C); const int Rb = Epi::PERM ? ((R & ~31) + perm32(R & 31)) : R;
        voffA[i] = (unsigned)(R * K + C) * 2u; voffB[i] = (unsigned)(Rb * K + C) * 2u; }
    const size_t kstep = (size_t)(BK * 2);
    const size_t hstep = (size_t)HALF * K * 2;
    const size_t tstep = 2 * hstep;
    const unsigned ldsw = (unsigned)wid * 1024u;
    const int aoff = lds_byte(wr * 64 + fr, fq * 8), boff = lds_byte(wc * 32 + fr, fq * 8);
#define PG8_SA(b, h) (((b) * 2 + (h)) * HTB)
#define PG8_SB(b, h) ((4 + (b) * 2 + (h)) * HTB)
#define PG8_STAGE(bufoff, gbase, voff) do { _Pragma("unroll") for (int _i = 0; _i < 2; ++_i) { unsigned vo_ = (voff)[_i]; if constexpr (FP8) asm volatile("" : "+v"(vo_));     \
        __builtin_amdgcn_global_load_lds((const unsigned*)((const char*)(gbase) + vo_), (PG8_LAS unsigned*)(lds + (bufoff) + ldsw + _i * 8192), 16, 0, 0); } } while (0)
#define PG8_LDA(dst, b, h) do { if constexpr (FP8) { _Pragma("unroll") for (int m = 0; m < 4; ++m) dst##8[m] = cat8(*(const PG8_LAS bf16x8*)(lds + PG8_SA(b, h) + aoff + m * 2048), *(const PG8_LAS bf16x8*)(lds + PG8_SA(b, h) + aoff + m * 2048 + 1024)); } else { \
        _Pragma("unroll") for (int m = 0; m < 4; ++m) _Pragma("unroll") for (int k = 0; k < 2; ++k) dst[m][k] = *(const PG8_LAS bf16x8*)(lds + PG8_SA(b, h) + aoff + m * 2048 + k * 1024); } } while (0)
#define PG8_LDB(dst, b, h) do { if constexpr (FP8) { _Pragma("unroll") for (int n = 0; n < 2; ++n) dst##8[n] = cat8(*(const PG8_LAS bf16x8*)(lds + PG8_SB(b, h) + boff + n * 2048), *(const PG8_LAS bf16x8*)(lds + PG8_SB(b, h) + boff + n * 2048 + 1024)); } else { \
        _Pragma("unroll") for (int n = 0; n < 2; ++n) _Pragma("unroll") for (int k = 0; k < 2; ++k) dst[n][k] = *(const PG8_LAS bf16x8*)(lds + PG8_SB(b, h) + boff + n * 2048 + k * 1024); } } while (0)
#define PG8_MMA(ai, bj, At, Bt) do { __builtin_amdgcn_s_setprio(1); if constexpr (FP8) { _Pragma("unroll") for (int m = 0; m < 4; ++m) _Pragma("unroll") for (int n = 0; n < 2; ++n) \
        acc[ai][bj][m][n] = __builtin_amdgcn_mfma_scale_f32_16x16x128_f8f6f4(Bt##8[n], At##8[m], acc[ai][bj][m][n], 0, 0, 0, 0, 0, 0); } else { \
        _Pragma("unroll") for (int m = 0; m < 4; ++m) _Pragma("unroll") for (int n = 0; n < 2; ++n) _Pragma("unroll") for (int k = 0; k < 2; ++k) \
        acc[ai][bj][m][n] = __builtin_amdgcn_mfma_f32_16x16x32_bf16(Bt[n][k], At[m][k], acc[ai][bj][m][n], 0, 0, 0); } __builtin_amdgcn_s_setprio(0); } while (0)
#define PG8_WAIT_V(n) asm volatile("s_waitcnt vmcnt(" #n ")" ::: "memory")
#define PG8_WAIT_L(n) asm volatile("s_waitcnt lgkmcnt(" #n ")" ::: "memory")
#define PG8_BAR __builtin_amdgcn_s_barrier()
#define PG8_SCHED __builtin_amdgcn_sched_barrier(0)
    Unit cur, nxt; int ui = 0;
    if (!S.next(0, cur)) return;
    f32x4 acc[2][2][4][2];
#pragma unroll
    for (int a = 0; a < 2; ++a)
#pragma unroll
        for (int b = 0; b < 2; ++b)
#pragma unroll
            for (int m = 0; m < 4; ++m)
#pragma unroll
                for (int n = 0; n < 2; ++n) acc[a][b][m][n] = (f32x4){0.f, 0.f, 0.f, 0.f};
    bf16x8 At[4][2], B0[2][2], B1[2][2]; i32x8 At8[4], B08[2], B18[2];
    const char* cA = (const char*)g.A + (size_t)cur.pm * tstep; const char* cB = (const char*)g.Bt + (size_t)cur.pb * tstep;
    S.a_ready(cur);
    if constexpr (SP2) {
        PG8_STAGE(PG8_SB(0, 0), cB, voffB); PG8_STAGE(PG8_SB(0, 1), cB + hstep, voffB); PG8_STAGE(PG8_SA(0, 0), cA, voffA); PG8_STAGE(PG8_SA(0, 1), cA + hstep, voffA);
        if (wr == 1) PG8_BAR;
        PG8_WAIT_V(2); PG8_BAR;
        PG8_STAGE(PG8_SB(1, 0), cB + kstep, voffB); PG8_STAGE(PG8_SA(1, 0), cA + kstep, voffA); PG8_STAGE(PG8_SB(1, 1), cB + hstep + kstep, voffB);
        PG8_WAIT_V(6); PG8_BAR;
    } else {
        PG8_STAGE(PG8_SB(0, 0), cB, voffB); PG8_STAGE(PG8_SA(0, 0), cA, voffA); PG8_STAGE(PG8_SB(0, 1), cB + hstep, voffB); PG8_STAGE(PG8_SA(0, 1), cA + hstep, voffA);
        if (wr == 1) PG8_BAR;
        PG8_WAIT_V(4); PG8_BAR;
        PG8_STAGE(PG8_SB(1, 0), cB + kstep, voffB); PG8_STAGE(PG8_SA(1, 0), cA + kstep, voffA); PG8_STAGE(PG8_SB(1, 1), cB + hstep + kstep, voffB);
        PG8_WAIT_V(6); PG8_BAR;
    }
    for (;;) {
        const bool has_next = S.next(ui + 1, nxt);
        const char* nA = has_next ? (const char*)g.A + (size_t)nxt.pm * tstep : cA; const char* nB = has_next ? (const char*)g.Bt + (size_t)nxt.pb * tstep : cB;
#pragma nounroll
        for (int t = 0; t < nt; t += 2) {
            const bool last = (t == nt - 2);
            const char* a1 = cA + (size_t)(t + 1) * kstep;
            const char* a2 = last ? nA : cA + (size_t)(t + 2) * kstep; const char* b2 = last ? nB : cB + (size_t)(t + 2) * kstep;
            const char* a3 = a2 + kstep; const char* b3 = b2 + kstep;
            if (last && has_next) S.a_ready(nxt);
            if constexpr (SP2) {
            PG8_LDB(B0, 0, 0); PG8_LDB(B1, 0, 1); PG8_SCHED; PG8_LDA(At, 0, 0); PG8_STAGE(PG8_SA(1, 1), a1 + hstep, voffA);
            PG8_WAIT_V(8); PG8_WAIT_L(0); PG8_BAR; PG8_MMA(0, 0, At, B0); PG8_MMA(0, 1, At, B1); PG8_BAR; PG8_SCHED;
            PG8_LDA(At, 0, 1); PG8_STAGE(PG8_SB(0, 0), b2, voffB); PG8_STAGE(PG8_SB(0, 1), b2 + hstep, voffB); PG8_STAGE(PG8_SA(0, 0), a2, voffA);
            PG8_WAIT_V(8); PG8_WAIT_L(0); PG8_BAR; PG8_MMA(1, 0, At, B0); PG8_MMA(1, 1, At, B1); PG8_BAR; PG8_SCHED;
            PG8_LDB(B0, 1, 0); PG8_LDB(B1, 1, 1); PG8_SCHED; PG8_LDA(At, 1, 0); PG8_STAGE(PG8_SA(0, 1), a2 + hstep, voffA);
            PG8_WAIT_V(8); PG8_WAIT_L(0); PG8_BAR; PG8_MMA(0, 0, At, B0); PG8_MMA(0, 1, At, B1); PG8_BAR; PG8_SCHED;
            PG8_LDA(At, 1, 1); PG8_STAGE(PG8_SB(1, 0), b3, voffB); PG8_STAGE(PG8_SB(1, 1), b3 + hstep, voffB); PG8_STAGE(PG8_SA(1, 0), a3, voffA);
            PG8_WAIT_V(8); PG8_WAIT_L(0); PG8_BAR; PG8_MMA(1, 0, At, B0); PG8_MMA(1, 1, At, B1); PG8_BAR; PG8_SCHED;
            } else {
            PG8_LDB(B0, 0, 0); PG8_SCHED; PG8_LDA(At, 0, 0); PG8_STAGE(PG8_SA(1, 1), a1 + hstep, voffA);
            PG8_WAIT_L(8); PG8_BAR; PG8_WAIT_L(0); PG8_MMA(0, 0, At, B0); PG8_BAR; PG8_SCHED;
            PG8_LDB(B1, 0, 1); PG8_STAGE(PG8_SB(0, 0), b2, voffB);
            PG8_BAR; PG8_WAIT_L(0); PG8_MMA(0, 1, At, B1); PG8_BAR;
            PG8_LDA(At, 0, 1); PG8_STAGE(PG8_SA(0, 0), a2, voffA);
            PG8_BAR; PG8_WAIT_L(0); PG8_MMA(1, 0, At, B0); PG8_BAR; PG8_SCHED;
            PG8_STAGE(PG8_SB(0, 1), b2 + hstep, voffB);
            PG8_WAIT_V(6); PG8_BAR; PG8_MMA(1, 1, At, B1); PG8_BAR;
            PG8_LDB(B0, 1, 0); PG8_SCHED; PG8_LDA(At, 1, 0); PG8_STAGE(PG8_SA(0, 1), a2 + hstep, voffA);
            PG8_WAIT_L(8); PG8_BAR; PG8_WAIT_L(0); PG8_MMA(0, 0, At, B0); PG8_BAR; PG8_SCHED;
            PG8_LDB(B1, 1, 1); PG8_STAGE(PG8_SB(1, 0), b3, voffB);
            PG8_BAR; PG8_WAIT_L(0); PG8_MMA(0, 1, At, B1); PG8_BAR;
            PG8_LDA(At, 1, 1); PG8_STAGE(PG8_SA(1, 0), a3, voffA);
            PG8_BAR; PG8_WAIT_L(0); PG8_MMA(1, 0, At, B0); PG8_BAR; PG8_SCHED;
            PG8_STAGE(PG8_SB(1, 1), b3 + hstep, voffB);
            PG8_WAIT_V(6); PG8_BAR; PG8_MMA(1, 1, At, B1); PG8_BAR;
            }
        }
        if constexpr (ALIGN_EPI) { if (wr == 0) PG8_BAR; }
        if constexpr (!Epi::AFTER_DRAIN) { if constexpr (FP8) { int l2_ = lane_id_asm(); E(acc, cur, wr, wc, l2_ & 15, l2_ >> 4); }
            else E(acc, cur, wr, wc, fr, fq); S.done(cur); }
        if (!has_next) break;
#pragma unroll
        for (int a = 0; a < 2; ++a)
#pragma unroll
            for (int b = 0; b < 2; ++b)
#pragma unroll
                for (int m = 0; m < 4; ++m)
#pragma unroll
                    for (int n = 0; n < 2; ++n) acc[a][b][m][n] = (f32x4){0.f, 0.f, 0.f, 0.f};
        cur = nxt; cA = nA; cB = nB; ++ui;
        if constexpr (ALIGN_EPI) { if (wr == 1) PG8_BAR; }
    }
    PG8_WAIT_V(0);
    if constexpr (!ALIGN_EPI) { if (wr == 0) PG8_BAR; }
    PG8_BAR;
    if constexpr (Epi::AFTER_DRAIN) { E.fused(acc, cur, wr, wc, fr, fq, lds, wid, lane); S.done(cur); }
#undef PG8_SA
#undef PG8_SB
#undef PG8_STAGE
#undef PG8_LDA
#undef PG8_LDB
#undef PG8_MMA
#undef PG8_WAIT_V
#undef PG8_WAIT_L
#undef PG8_BAR
#undef PG8_SCHED
}
template <class Epi, class Sched, bool FP8 = false>
__device__ __forceinline__ void gemm_phase_gather(PG8_LAS unsigned char* lds, const Gemm g, const Sched& S, const Epi& E, const int wave, const int* rowidx) {
    constexpr bool ALIGN_EPI = true, SP2 = true;
    int lane_ = lane_id_asm();
    const int wid = wave, lane = lane_, tid = wid * 64 + lane, wr = wid >> 2, wc = wid & 3, fr = lane & 15, fq = lane >> 4;
    const int K = g.K, nt = K / BK;
    unsigned voffB[2];
#pragma unroll
    for (int i = 0; i < 2; ++i) { int R, C; stage_rc(tid * 16 + i * 8192, R, C); const int Rb = Epi::PERM ? ((R & ~31) + perm32(R & 31)) : R;
        voffB[i] = (unsigned)(Rb * K + C) * 2u; }
    unsigned oC[2][2], oN[2][2];
#define PG8_GOFF(dst, u) do { _Pragma("unroll") for (int i_ = 0; i_ < 2; ++i_) { int R_, C_; stage_rc(tid * 16 + i_ * 8192, R_, C_); _Pragma("unroll") for (int h_ = 0; h_ < 2; ++h_) dst[h_][i_] = (unsigned)rowidx[(u).pm * BM + h_ * HALF + R_] * (unsigned)(K * 2) + (unsigned)(C_ * 2); } } while (0)
    const size_t kstep = (size_t)(BK * 2);
    const size_t hstep = (size_t)HALF * K * 2;
    const size_t tstep = 2 * hstep;
    const unsigned ldsw = (unsigned)wid * 1024u;
    const int aoff = lds_byte(wr * 64 + fr, fq * 8), boff = lds_byte(wc * 32 + fr, fq * 8);
#define PG8_SA(b, h) (((b) * 2 + (h)) * HTB)
#define PG8_SB(b, h) ((4 + (b) * 2 + (h)) * HTB)
#define PG8_STAGE(bufoff, gbase, voff) do { _Pragma("unroll") for (int _i = 0; _i < 2; ++_i) { unsigned vo_ = (voff)[_i]; if constexpr (FP8) asm volatile("" : "+v"(vo_));     \
        __builtin_amdgcn_global_load_lds((const unsigned*)((const char*)(gbase) + vo_), (PG8_LAS unsigned*)(lds + (bufoff) + ldsw + _i * 8192), 16, 0, 0); } } while (0)
#define PG8_LDA(dst, b, h) do { if constexpr (FP8) { _Pragma("unroll") for (int m = 0; m < 4; ++m) dst##8[m] = cat8(*(const PG8_LAS bf16x8*)(lds + PG8_SA(b, h) + aoff + m * 2048), *(const PG8_LAS bf16x8*)(lds + PG8_SA(b, h) + aoff + m * 2048 + 1024)); } else { \
        _Pragma("unroll") for (int m = 0; m < 4; ++m) _Pragma("unroll") for (int k = 0; k < 2; ++k) dst[m][k] = *(const PG8_LAS bf16x8*)(lds + PG8_SA(b, h) + aoff + m * 2048 + k * 1024); } } while (0)
#define PG8_LDB(dst, b, h) do { if constexpr (FP8) { _Pragma("unroll") for (int n = 0; n < 2; ++n) dst##8[n] = cat8(*(const PG8_LAS bf16x8*)(lds + PG8_SB(b, h) + boff + n * 2048), *(const PG8_LAS bf16x8*)(lds + PG8_SB(b, h) + boff + n * 2048 + 1024)); } else { \
        _Pragma("unroll") for (int n = 0; n < 2; ++n) _Pragma("unroll") for (int k = 0; k < 2; ++k) dst[n][k] = *(const PG8_LAS bf16x8*)(lds + PG8_SB(b, h) + boff + n * 2048 + k * 1024); } } while (0)
#define PG8_MMA(ai, bj, At, Bt) do { __builtin_amdgcn_s_setprio(1); if constexpr (FP8) { _Pragma("unroll") for (int m = 0; m < 4; ++m) _Pragma("unroll") for (int n = 0; n < 2; ++n) \
        acc[ai][bj][m][n] = __builtin_amdgcn_mfma_scale_f32_16x16x128_f8f6f4(Bt##8[n], At##8[m], acc[ai][bj][m][n], 0, 0, 0, 0, 0, 0); } else { \
        _Pragma("unroll") for (int m = 0; m < 4; ++m) _Pragma("unroll") for (int n = 0; n < 2; ++n) _Pragma("unroll") for (int k = 0; k < 2; ++k) \
        acc[ai][bj][m][n] = __builtin_amdgcn_mfma_f32_16x16x32_bf16(Bt[n][k], At[m][k], acc[ai][bj][m][n], 0, 0, 0); } __builtin_amdgcn_s_setprio(0); } while (0)
#define PG8_WAIT_V(n) asm volatile("s_waitcnt vmcnt(" #n ")" ::: "memory")
#define PG8_WAIT_L(n) asm volatile("s_waitcnt lgkmcnt(" #n ")" ::: "memory")
#define PG8_BAR __builtin_amdgcn_s_barrier()
#define PG8_SCHED __builtin_amdgcn_sched_barrier(0)
    Unit cur, nxt; int ui = 0;
    if (!S.next(0, cur)) return;
    f32x4 acc[2][2][4][2];
#pragma unroll
    for (int a = 0; a < 2; ++a)
#pragma unroll
        for (int b = 0; b < 2; ++b)
#pragma unroll
            for (int m = 0; m < 4; ++m)
#pragma unroll
                for (int n = 0; n < 2; ++n) acc[a][b][m][n] = (f32x4){0.f, 0.f, 0.f, 0.f};
    bf16x8 At[4][2], B0[2][2], B1[2][2]; i32x8 At8[4], B08[2], B18[2];
    const char* const gA = (const char*)g.A; const char* cB = (const char*)g.Bt + (size_t)cur.pb * tstep;
    S.a_ready(cur);
    PG8_GOFF(oC, cur);
    {
        PG8_STAGE(PG8_SB(0, 0), cB, voffB); PG8_STAGE(PG8_SB(0, 1), cB + hstep, voffB); PG8_STAGE(PG8_SA(0, 0), gA, oC[0]); PG8_STAGE(PG8_SA(0, 1), gA, oC[1]);
        if (wr == 1) PG8_BAR;
        PG8_WAIT_V(2); PG8_BAR;
        PG8_STAGE(PG8_SB(1, 0), cB + kstep, voffB); PG8_STAGE(PG8_SA(1, 0), gA + kstep, oC[0]); PG8_STAGE(PG8_SB(1, 1), cB + hstep + kstep, voffB);
        PG8_WAIT_V(6); PG8_BAR;
    }
    for (;;) {
        const bool has_next = S.next(ui + 1, nxt);
        const char* nB = has_next ? (const char*)g.Bt + (size_t)nxt.pb * tstep : cB;
        if (has_next) PG8_GOFF(oN, nxt); else { _Pragma("unroll") for (int h_ = 0; h_ < 2; ++h_) _Pragma("unroll") for (int i_ = 0; i_ < 2; ++i_) oN[h_][i_] = oC[h_][i_]; }
#pragma nounroll
        for (int t = 0; t < nt; t += 2) {
            const bool last = (t == nt - 2);
            const char* a1 = gA + (size_t)(t + 1) * kstep;
            const char* a2 = last ? gA : gA + (size_t)(t + 2) * kstep; const char* b2 = last ? nB : cB + (size_t)(t + 2) * kstep;
            const char* a3 = a2 + kstep; const char* b3 = b2 + kstep;
            unsigned o2[2][2];
            _Pragma("unroll") for (int h_ = 0; h_ < 2; ++h_) _Pragma("unroll") for (int i_ = 0; i_ < 2; ++i_) o2[h_][i_] = last ? oN[h_][i_] : oC[h_][i_];
            if (last && has_next) S.a_ready(nxt);
            {
            PG8_LDB(B0, 0, 0); PG8_LDB(B1, 0, 1); PG8_SCHED; PG8_LDA(At, 0, 0); PG8_STAGE(PG8_SA(1, 1), a1, oC[1]);
            PG8_WAIT_V(8); PG8_WAIT_L(0); PG8_BAR; PG8_MMA(0, 0, At, B0); PG8_MMA(0, 1, At, B1); PG8_BAR; PG8_SCHED;
            PG8_LDA(At, 0, 1); PG8_STAGE(PG8_SB(0, 0), b2, voffB); PG8_STAGE(PG8_SB(0, 1), b2 + hstep, voffB); PG8_STAGE(PG8_SA(0, 0), a2, o2[0]);
            PG8_WAIT_V(8); PG8_WAIT_L(0); PG8_BAR; PG8_MMA(1, 0, At, B0); PG8_MMA(1, 1, At, B1); PG8_BAR; PG8_SCHED;
            PG8_LDB(B0, 1, 0); PG8_LDB(B1, 1, 1); PG8_SCHED; PG8_LDA(At, 1, 0); PG8_STAGE(PG8_SA(0, 1), a2, o2[1]);
            PG8_WAIT_V(8); PG8_WAIT_L(0); PG8_BAR; PG8_MMA(0, 0, At, B0); PG8_MMA(0, 1, At, B1); PG8_BAR; PG8_SCHED;
            PG8_LDA(At, 1, 1); PG8_STAGE(PG8_SB(1, 0), b3, voffB); PG8_STAGE(PG8_SB(1, 1), b3 + hstep, voffB); PG8_STAGE(PG8_SA(1, 0), a3, o2[0]);
            PG8_WAIT_V(8); PG8_WAIT_L(0); PG8_BAR; PG8_MMA(1, 0, At, B0); PG8_MMA(1, 1, At, B1); PG8_BAR; PG8_SCHED;
            }
        }
        if constexpr (ALIGN_EPI) { if (wr == 0) PG8_BAR; }
        if constexpr (!Epi::AFTER_DRAIN) { if constexpr (FP8) { int l2_ = lane_id_asm(); E(acc, cur, wr, wc, l2_ & 15, l2_ >> 4); }
            else E(acc, cur, wr, wc, fr, fq); S.done(cur); }
        if (!has_next) break;
#pragma unroll
        for (int a = 0; a < 2; ++a)
#pragma unroll
            for (int b = 0; b < 2; ++b)
#pragma unroll
                for (int m = 0; m < 4; ++m)
#pragma unroll
                    for (int n = 0; n < 2; ++n) acc[a][b][m][n] = (f32x4){0.f, 0.f, 0.f, 0.f};
        cur = nxt; cB = nB; ++ui;
        _Pragma("unroll") for (int h_ = 0; h_ < 2; ++h_) _Pragma("unroll") for (int i_ = 0; i_ < 2; ++i_) oC[h_][i_] = oN[h_][i_];
        if constexpr (ALIGN_EPI) { if (wr == 1) PG8_BAR; }
    }
    PG8_WAIT_V(0);
    if constexpr (!ALIGN_EPI) { if (wr == 0) PG8_BAR; }
    PG8_BAR;
    if constexpr (Epi::AFTER_DRAIN) { E.fused(acc, cur, wr, wc, fr, fq, lds, wid, lane); S.done(cur); }
#undef PG8_GOFF
#undef PG8_SA
#undef PG8_SB
#undef PG8_STAGE
#undef PG8_LDA
#undef PG8_LDB
#undef PG8_MMA
#undef PG8_WAIT_V
#undef PG8_WAIT_L
#undef PG8_BAR
#undef PG8_SCHED
}
}

#ifndef PG8_SP2
#define PG8_SP2 true
#endif
#ifndef PG8_ALIGN
#define PG8_ALIGN true
#endif

constexpr int SEQ = 8192, DM = 2048, DEPTH = 2;
constexpr int DSSM = 1024, NG = 64, SG = 16, SP = 64;
constexpr int DATT = 1024, NHEAD = 8, HD = 64, NHH = 16;
constexpr int INC = 8192;
constexpr int NE = 16, DE = 1024, CAP = 1024;
constexpr float EPS = 1e-6f;
constexpr float QSCALE = 0.125f * 1.4426950408889634f;
constexpr int NWAVES = 8;

constexpr size_t MiB = 1u << 20;
constexpr size_t WS_CTL = 0, CTL_ZERO_BYTES = 1 * MiB;
constexpr size_t WS_SCAL = 1 * MiB;
constexpr size_t WS_ROPEC = 2 * MiB, WS_ROPES = 2 * MiB + 256 * 1024;
constexpr size_t WS_QNRM = 3 * MiB;
constexpr size_t WS_EMAT = 4 * MiB;
constexpr size_t WS_WMAT = 20 * MiB;
constexpr size_t WS_LAMB = 52 * MiB;
constexpr size_t WS_WRT = 53 * MiB;
constexpr size_t WS_BBAR = 53 * MiB;
constexpr size_t WS_WIN = 56 * MiB;
constexpr size_t WIN8_OFF = 16 * MiB;
constexpr size_t WS_H8 = 910 * MiB;
constexpr size_t WS_WGLU = 120 * MiB;
constexpr size_t WS_WBS = 124 * MiB;
constexpr size_t WS_WBA = 132 * MiB;
constexpr size_t WS_WOUT = 140 * MiB;
constexpr size_t WS_WGU = 156 * MiB;
constexpr size_t WS_WD = 412 * MiB;
constexpr size_t WS_XB = 540 * MiB;
constexpr size_t WS_HN = 604 * MiB;
constexpr size_t WS_U = 636 * MiB, WS_QRAW = 652 * MiB, WS_KRAW = 668 * MiB, WS_V = 684 * MiB;
static_assert(WS_KRAW == WS_QRAW + 16 * MiB && WS_V == WS_QRAW + 32 * MiB, "EpiInProj addresses q | k | v from the q base");
constexpr size_t WS_GATE = 700 * MiB;
constexpr size_t WS_QN = 764 * MiB, WS_KN = 780 * MiB;
constexpr size_t WS_YS = 796 * MiB, WS_YS2 = 812 * MiB, WS_YA = 828 * MiB;
constexpr size_t WS_MERGED = 844 * MiB;
constexpr size_t WS_AFF = 876 * MiB;
constexpr size_t WS_SEL = 876 * MiB + 512 * 1024;
constexpr size_t WS_IDX = 877 * MiB;
constexpr size_t WS_GW = 877 * MiB + 64 * 1024;
constexpr size_t WS_SSME = 878 * MiB;
constexpr size_t WS_ATMP = 910 * MiB;
constexpr size_t WS_NAO = 942 * MiB;
constexpr size_t WS_HE = WS_QRAW;
constexpr size_t WS_XE = WS_GATE;
constexpr size_t WS_YE = WS_GATE;
constexpr size_t WS_END = 1006 * MiB;
constexpr int CW_TMO = 0, CW_CODE = 1;
constexpr int CW_ITEM = 1024;
constexpr int CW_KMAX = 64;
constexpr int CW_BAR = 4096;

constexpr int RING_OFF = 0, RING_BYTES = 139264;
constexpr int LDSCTL_OFF = RING_BYTES, MISC_OFF = LDSCTL_OFF + 320;
constexpr int LDS_BYTES = 147456;

#define GAS __attribute__((address_space(1)))
#define LAS __attribute__((address_space(3)))
typedef unsigned short bf16;
typedef unsigned v4u __attribute__((ext_vector_type(4)));
typedef unsigned v2u __attribute__((ext_vector_type(2)));
typedef float f32x4 __attribute__((ext_vector_type(4)));
typedef GAS unsigned gu32;
#define RLX_AGENT __ATOMIC_RELAXED, __HIP_MEMORY_SCOPE_AGENT
#define LDS_WAIT() asm volatile("s_waitcnt lgkmcnt(0)" ::: "memory")
#define VM_WAIT() asm volatile("s_waitcnt vmcnt(0)" ::: "memory")
__device__ __forceinline__ unsigned f2bf(float f) { unsigned u = __builtin_bit_cast(unsigned, f); return (u + 0x7fffu + ((u >> 16) & 1u)) >> 16; }
__device__ __forceinline__ unsigned pk2(float lo, float hi) { return f2bf(lo) | (f2bf(hi) << 16); }
__device__ __forceinline__ float bflo(unsigned w) { return __uint_as_float(w << 16); }
__device__ __forceinline__ float bfhi(unsigned w) { return __uint_as_float(w & 0xffff0000u); }
__device__ __forceinline__ float bf2f(bf16 b) { return __uint_as_float(((unsigned)b) << 16); }

#define XB_TMO      128
#define XB_XCNT(j)  (256  + 64 * (j))
#define XB_XSUB(j)  (1280 + 64 * (j))
#define XB_XGEN(j)  (2304 + 64 * (j))
#define XB_TOP      3328
#define XB_TOPGEN   3392
#define XCD_BAR_WORDS 3456
#define XB_SPIN_CAP (1u << 18)

__device__ __forceinline__ unsigned xb_ld(unsigned* p)              { return __hip_atomic_load(p, __ATOMIC_RELAXED, __HIP_MEMORY_SCOPE_AGENT); }
__device__ __forceinline__ unsigned xb_add(unsigned* p, unsigned v) { return __hip_atomic_fetch_add(p, v, __ATOMIC_RELAXED, __HIP_MEMORY_SCOPE_AGENT); }
__device__ __forceinline__ unsigned xb_xcc_id() { return (unsigned)__builtin_amdgcn_s_getreg((3 << 11) | 20) & 0xFu; }
#define XB_SPIN(cond, bar) do { unsigned _sp = 0; while (cond) { __builtin_amdgcn_s_sleep(1); \
    if ((++_sp & 255u) == 0u) { if (xb_ld(&(bar)[XB_TMO])) break; if (_sp > XB_SPIN_CAP) { atomicAdd(&(bar)[XB_TMO], 1u); break; } } } } while (0)

struct XcdBarrier {
    unsigned* bar; unsigned x; unsigned w0;
    volatile LAS unsigned* st;
};

__device__ __forceinline__ bool xb_lane0() { return lane_id_asm() == 0; }
__device__ __forceinline__ XcdBarrier xcd_barrier_post(unsigned* bar, volatile LAS unsigned* st, unsigned w0) {
    XcdBarrier b; b.bar = bar; b.x = xb_xcc_id(); b.st = st; b.w0 = w0;
    if (w0 && xb_lane0()) (void)xb_add(&bar[XB_XCNT(b.x)], 1u);
    return b;
}
__device__ __forceinline__ void xcd_barrier_complete(unsigned* bar, unsigned x, unsigned& nloc, unsigned& nx) {
    const unsigned G = gridDim.x * gridDim.y * gridDim.z;
    unsigned sum, cnt, mine, sp = 0u;
    for (;;) {
        sum = 0u; cnt = 0u; mine = 0u;
#pragma unroll
        for (unsigned j = 0; j < 16; ++j) { const unsigned c = xb_ld(&bar[XB_XCNT(j)]); sum += c; cnt += (c > 0u) ? 1u : 0u; mine = (j == x) ? c : mine; }
        if (sum == G) break;
        __builtin_amdgcn_s_sleep(1);
        if ((++sp & 255u) == 0u) { if (xb_ld(&bar[XB_TMO])) break; if (sp > XB_SPIN_CAP) { atomicAdd(&bar[XB_TMO], 1u); break; } }
    }
    nloc = mine > 0u ? mine : 1u; nx = cnt > 0u ? cnt : 1u;
}

__device__ __forceinline__ void xcd_barrier(const XcdBarrier& b) {
    asm volatile("s_waitcnt vmcnt(0)" ::: "memory");
    __syncthreads();
    if (b.w0 && xb_lane0()) {
        unsigned* bar = b.bar;
        __builtin_amdgcn_s_waitcnt(0);
        unsigned nloc = b.st[0], nx = b.st[1];
        if (nloc == 0u) { xcd_barrier_complete(bar, b.x, nloc, nx); b.st[0] = nloc; b.st[1] = nx; }
        const unsigned old = xb_add(&bar[XB_XSUB(b.x)], 1u);
        const unsigned gen = old / nloc;
        if (old + 1u == (gen + 1u) * nloc) {
            __builtin_amdgcn_fence(__ATOMIC_RELEASE, "agent");
            asm volatile("s_waitcnt vmcnt(0)" ::: "memory");
            const unsigned og = xb_add(&bar[XB_TOP], 1u);
            const unsigned tg = og / nx;
            if (og + 1u == (tg + 1u) * nx) xb_add(&bar[XB_TOPGEN], 1u);
            else XB_SPIN(xb_ld(&bar[XB_TOPGEN]) == tg, bar);
            __builtin_amdgcn_fence(__ATOMIC_ACQUIRE, "agent");
            xb_add(&bar[XB_XGEN(b.x)], 1u);
            asm volatile("s_waitcnt vmcnt(0)" ::: "memory");
        } else {
            XB_SPIN(xb_ld(&bar[XB_XGEN(b.x)]) == gen, bar);
            __builtin_amdgcn_fence(__ATOMIC_ACQUIRE, "agent");
            asm volatile("s_waitcnt vmcnt(0)" ::: "memory");
        }
    }
    __syncthreads();
}

struct Args { const float* in[28]; float* out; unsigned char* ws; int ph_lo, ph_hi, bar_idx, pad; };
struct Frame {
    LAS unsigned char* lds;
    volatile LAS unsigned* MISC;
    gu32* ctl;
    GAS unsigned char* ws; GAS float* out;
    int wave, vcu, G;
};
__device__ __forceinline__ int fresh_v(int x) { asm volatile("" : "+v"(x)); return x; }
__device__ __forceinline__ int lane_fresh() { return lane_id_asm(); }
__device__ __forceinline__ int fresh_s(int x) { asm volatile("" : "+s"(x)); return x; }
__device__ __forceinline__ float bperm_f(int srclane, float v) { return __int_as_float(__builtin_amdgcn_ds_bpermute(srclane << 2, __float_as_int(v))); }
__device__ __forceinline__ int bperm_i(int srclane, int v) { return __builtin_amdgcn_ds_bpermute(srclane << 2, v); }
__device__ __forceinline__ float wave_sum(float v, int lane) {
#pragma unroll
    for (int o = 1; o < 64; o <<= 1) v += bperm_f(lane ^ o, v);
    return v;
}
__device__ __forceinline__ float lam_init_of(int l) { return 0.8f - 0.6f * expf(-0.3f * (float)l); }

struct TrItem { const float* src; unsigned char* dst; int N, K, k0; bool is8; };
__device__ __forceinline__ void tr_load(const TrItem& d, f32x4 (&v)[16]) {
    const GAS f32x4* src = (const GAS f32x4*)d.src;
#pragma unroll
    for (int i = 0; i < 16; ++i) v[i] = src[(size_t)i * d.N];
}
__device__ __forceinline__ void tr_store(const TrItem& d, const f32x4 (&v)[16], LAS unsigned char* scr8, int lane) {
    const int kq = lane >> 4, n4 = (lane & 15) * 4;
    if (d.is8) {
#pragma unroll
        for (int i = 0; i < 16; ++i) { const unsigned w = pg8::pack4_fp8(v[i].x * pg8::F8_WSCALE, v[i].y * pg8::F8_WSCALE, v[i].z * pg8::F8_WSCALE, v[i].w * pg8::F8_WSCALE);
            scr8[(n4 + 0) * 80 + 4 * i + kq] = (unsigned char)(w & 0xffu); scr8[(n4 + 1) * 80 + 4 * i + kq] = (unsigned char)((w >> 8) & 0xffu);
            scr8[(n4 + 2) * 80 + 4 * i + kq] = (unsigned char)((w >> 16) & 0xffu); scr8[(n4 + 3) * 80 + 4 * i + kq] = (unsigned char)(w >> 24); }
        LDS_WAIT(); asm volatile("" ::: "memory");
        const int c = lane & 3;
#pragma unroll
        for (int j = 0; j < 4; ++j) { const int n = (lane >> 2) + 16 * j; const v4u o = *(const LAS v4u*)(scr8 + n * 80 + 16 * c);
            *(GAS v4u*)(d.dst + (size_t)n * d.K + d.k0 + 16 * c) = o; }
    } else {
        LAS bf16* scr = (LAS bf16*)scr8;
#pragma unroll
        for (int i = 0; i < 16; ++i) { const unsigned a = pk2(v[i].x, v[i].y), b = pk2(v[i].z, v[i].w);
            scr[(n4 + 0) * 72 + 4 * i + kq] = (bf16)(a & 0xffffu); scr[(n4 + 1) * 72 + 4 * i + kq] = (bf16)(a >> 16);
            scr[(n4 + 2) * 72 + 4 * i + kq] = (bf16)(b & 0xffffu); scr[(n4 + 3) * 72 + 4 * i + kq] = (bf16)(b >> 16); }
        LDS_WAIT(); asm volatile("" ::: "memory");
        const int c = lane & 7;
#pragma unroll
        for (int j = 0; j < 8; ++j) { const int n = (lane >> 3) + 8 * j; const v4u o = *(const LAS v4u*)(scr + n * 72 + 8 * c);
            *(GAS v4u*)((bf16*)d.dst + (size_t)n * d.K + d.k0 + 8 * c) = o; }
    }
    LDS_WAIT(); asm volatile("" ::: "memory");
}
__device__ __forceinline__ void ssm_tables_unit(Frame& F, const Args& a, int l, int g);
constexpr int P0_I_PER_E = 2 * 32 * 16 + 16 * 32, P0_I_PER_L = 32 * 128 + 16 * 16 + 2 * 16 * 32 + 32 * 32 + 16 * P0_I_PER_E, P0_I_TOTAL = 2 * P0_I_PER_L;
constexpr int P0_DEF_TOPK = 5, P0_DEF_GLU = 3, P0_DEFER = (2 * P0_DEF_TOPK + 2 * P0_DEF_GLU) * P0_I_PER_E;
constexpr int P0_END_TOPK0 = 0, P0_END_GLU0 = P0_DEF_TOPK, P0_END_GLU1 = P0_DEF_TOPK + P0_DEF_GLU, P0_END_TOPK1 = P0_DEF_TOPK + 2 * P0_DEF_GLU;
template <bool DYN> __device__ __forceinline__ void convert_items(Frame& F, const Args& a, const int it0, const int it1, const int gw, const int NGW) {
    LAS unsigned char* scr = (LAS unsigned char*)(F.lds + RING_OFF + F.wave * 16384);
    const int lane_ = lane_fresh();
    constexpr int I_IN = 32 * 128, I_GLU = 16 * 16, I_BR = 16 * 32, I_OUT = 32 * 32, I_EG = 32 * 16, I_ED = 16 * 32;
    constexpr int PER_L = I_IN + I_GLU + 2 * I_BR + I_OUT + 16 * (2 * I_EG + I_ED), TOTAL = DEPTH * PER_L;
    auto decode = [&](int it, TrItem& d) {
        const int l = it / PER_L; int r = it % PER_L;
        const float* W; int K, N; unsigned char* dst; int mode = 0; bool is8 = false;
        if (r < I_IN) { W = a.in[2] + (size_t)l * DM * INC; K = DM; N = INC; dst = (unsigned char*)(F.ws + WS_WIN + (size_t)l * INC * DM * 2); mode = 3; }
        else if ((r -= I_IN) < I_GLU) { W = a.in[12] + (size_t)l * DSSM * DSSM; K = DSSM; N = DSSM; dst = (unsigned char*)(F.ws + WS_WGLU + (size_t)l * DSSM * DSSM * 2); }
        else if ((r -= I_GLU) < I_BR) { W = a.in[20] + (size_t)l * DSSM * DM; K = DSSM; N = DM; dst = (unsigned char*)(F.ws + WS_WBS + (size_t)l * DM * DSSM * 2); }
        else if ((r -= I_BR) < I_BR) { W = a.in[21] + (size_t)l * DATT * DM; K = DATT; N = DM; dst = (unsigned char*)(F.ws + WS_WBA + (size_t)l * DM * DATT * 2); }
        else if ((r -= I_BR) < I_OUT) { W = a.in[22] + (size_t)l * DM * DM; K = DM; N = DM; dst = (unsigned char*)(F.ws + WS_WOUT + (size_t)l * DM * DM * 2); }
        else { r -= I_OUT; constexpr int PER_E = 2 * I_EG + I_ED; const int e = r / PER_E; r %= PER_E; const size_t le = (size_t)l * NE + e;
            is8 = true;
            if (r < I_EG) { W = a.in[25] + le * DM * DE; K = DM; N = DE; dst = (unsigned char*)(F.ws + WS_WGU + le * 2048 * 2048); mode = 1; }
            else if ((r -= I_EG) < I_EG) { W = a.in[26] + le * DM * DE; K = DM; N = DE; dst = (unsigned char*)(F.ws + WS_WGU + le * 2048 * 2048); mode = 2; }
            else { r -= I_EG; W = a.in[27] + le * DE * DM; K = DE; N = DM; dst = (unsigned char*)(F.ws + WS_WD + le * 2048 * 1024); } }
        const int nblk = N / 64, kb = r / nblk, nb = r % nblk, n0 = 64 * nb;
        int drow = (mode == 0 || mode == 3) ? n0 : ((n0 >> 7) * 256 + (n0 & 127) + (mode == 2 ? 128 : 0));
        if (mode == 3 && n0 >= 4096) { is8 = true; dst += WIN8_OFF; drow = n0 - 4096; }
        d.src = W + (size_t)(64 * kb + (lane_ >> 4)) * N + n0 + (lane_ & 15) * 4; d.N = N; d.K = K; d.k0 = 64 * kb; d.is8 = is8;
        d.dst = dst + (size_t)drow * K * (is8 ? 1 : 2);
    };
    static_assert(PER_L == P0_I_PER_L, "item count");
    { TrItem dA, dB; f32x4 vA[16], vB[16];
      const int grp = fresh_s(F.vcu) >> 3;
      auto grab = [&]() -> int { int v = 0; if (lane_ == 0) v = (int)__hip_atomic_fetch_add((unsigned*)(F.ctl + CW_ITEM + grp * 64), 1u, RLX_AGENT); v = __builtin_amdgcn_readfirstlane(v);
          return it0 + ((v >> 3) * 32 + grp) * 8 + (v & 7); };
      int it = DYN ? grab() : it0 + gw; const int TOTAL_ = it1; bool hasA = it < TOTAL_;
      if (hasA) { decode(it, dA); tr_load(dA, vA); }
      while (hasA) {
          const int itB = DYN ? grab() : it + NGW; const bool hasB = itB < TOTAL_;
          if (hasB) { decode(itB, dB); tr_load(dB, vB); }
          tr_store(dA, vA, scr, lane_);
          if (!hasB) break;
          it = DYN ? grab() : itB + NGW; hasA = it < TOTAL_;
          if (hasA) { decode(it, dA); tr_load(dA, vA); }
          tr_store(dB, vB, scr, lane_);
      } }
}
__device__ __forceinline__ void p0_prologue(Frame& F, const Args& a) {
    const bool dyn = F.G == 256;
    if (dyn) { const int v = fresh_s(F.vcu); if (!(v & 1) && (v >> 1) < DEPTH * NG) ssm_tables_unit(F, a, (v >> 1) / NG, (v >> 1) % NG); }
    else for (int u = fresh_s(F.vcu); u < DEPTH * NG; u += F.G) ssm_tables_unit(F, a, u / NG, u % NG);
    const int gw = fresh_s(F.vcu * NWAVES + F.wave), NGW = F.G * NWAVES, lane_ = lane_fresh();
    static_assert((DEPTH * P0_I_PER_L - P0_DEFER) % 256 == 0, "dynamic deal: 32 groups x chunks of 8");
    if (dyn) convert_items<true>(F, a, 0, DEPTH * P0_I_PER_L - P0_DEFER, gw, NGW); else convert_items<false>(F, a, 0, DEPTH * P0_I_PER_L - P0_DEFER, gw, NGW);
    const int gt = gw * 64 + lane_, NT = NGW * 64;
    float* ropec = (float*)(F.ws + WS_ROPEC); float* ropes = (float*)(F.ws + WS_ROPES);
    for (int i = gt; i < SEQ * 8; i += NT) { const int pos = i >> 3, k = i & 7; const float inv = powf(500000.0f, -(float)(2 * k) / 16.0f); const float ang = (float)pos * inv;
        ropec[i] = (float)cos((double)ang); ropes[i] = (float)sin((double)ang); }
    if (gw < DEPTH) { const int l = gw;
        const float s1 = wave_sum(a.in[15][l * HD + lane_] * a.in[16][l * HD + lane_], lane_), s2 = wave_sum(a.in[17][l * HD + lane_] * a.in[18][l * HD + lane_], lane_);
        if (lane_ == 0) ((float*)(F.ws + WS_SCAL))[l] = expf(s1) - expf(s2) + lam_init_of(l); }
    { float* wrt = (float*)(F.ws + WS_WRT);
      for (int i = gt; i < DEPTH * NE * DM; i += NT) { const int l = i / (NE * DM), e = (i / DM) % NE, d = i % DM; wrt[i] = a.in[23][(size_t)l * DM + d] * a.in[24][((size_t)l * DM + d) * NE + e]; } }
}

__device__ __forceinline__ void phase_norm_rows(Frame& F_, const float* xin, float* xout, const bf16* ye, const int* sel, const float* g, bf16* hn, unsigned char* h8 = nullptr) {
    struct { int lane; } F{lane_fresh()};
    const int gw = fresh_s(F_.vcu * NWAVES + F_.wave), NGW = F_.G * NWAVES;
    f32x4 gv[8];
    if (hn) { const GAS f32x4* gr = (const GAS f32x4*)g + F.lane;
#pragma unroll
        for (int j = 0; j < 8; ++j) gv[j] = gr[64 * j]; }
    f32x4 vn[8]; int seln = -1;
    if (gw < SEQ) { const GAS f32x4* xr = (const GAS f32x4*)(xin + (size_t)gw * DM) + F.lane; if (ye) seln = sel[gw * NE + (F.lane & 15)];
#pragma unroll
        for (int j = 0; j < 8; ++j) vn[j] = xr[64 * j]; }
    for (int t = gw; t < SEQ; t += NGW) {
        f32x4 v[8];
#pragma unroll
        for (int j = 0; j < 8; ++j) v[j] = vn[j];
        const int selv = seln;
        { const int tn = t + NGW;
          if (tn < SEQ) { const GAS f32x4* xr = (const GAS f32x4*)(xin + (size_t)tn * DM) + F.lane; if (ye) seln = sel[tn * NE + (F.lane & 15)];
#pragma unroll
              for (int j = 0; j < 8; ++j) vn[j] = xr[64 * j]; } }
        if (ye) {
            unsigned m = (unsigned)(__ballot(selv >= 0) & 0xffffull);
            while (m) { const int e0 = __builtin_ctz(m); m &= m - 1; const int s0 = __builtin_amdgcn_readlane(selv, e0);
                const bool two = m != 0u; const int e1 = two ? __builtin_ctz(m) : e0; if (two) m &= m - 1; const int s1 = __builtin_amdgcn_readlane(selv, e1);
                const GAS v2u* y0 = (const GAS v2u*)(ye + (size_t)(e0 * CAP + s0) * DM) + F.lane; const GAS v2u* y1 = (const GAS v2u*)(ye + (size_t)(e1 * CAP + s1) * DM) + F.lane;
                v2u a[8], b[8];
#pragma unroll
                for (int j = 0; j < 8; ++j) a[j] = y0[64 * j];
                if (two) {
#pragma unroll
                    for (int j = 0; j < 8; ++j) b[j] = y1[64 * j]; }
#pragma unroll
                for (int j = 0; j < 8; ++j) { v[j].x += bflo(a[j].x); v[j].y += bfhi(a[j].x); v[j].z += bflo(a[j].y); v[j].w += bfhi(a[j].y); }
                if (two) {
#pragma unroll
                    for (int j = 0; j < 8; ++j) { v[j].x += bflo(b[j].x); v[j].y += bfhi(b[j].x); v[j].z += bflo(b[j].y); v[j].w += bfhi(b[j].y); } } }
        }
        if (xout) { GAS f32x4* xo = (GAS f32x4*)(xout + (size_t)t * DM) + F.lane;
#pragma unroll
            for (int j = 0; j < 8; ++j) xo[64 * j] = v[j]; }
        if (hn) {
            float ss = 0.f;
#pragma unroll
            for (int j = 0; j < 8; ++j) ss += (v[j].x * v[j].x + v[j].y * v[j].y) + (v[j].z * v[j].z + v[j].w * v[j].w);
            const float rstd = rsqrtf(wave_sum(ss, F.lane) * (1.f / DM) + EPS);
            GAS v2u* o8 = (GAS v2u*)(hn + (size_t)t * DM) + F.lane;
#pragma unroll
            for (int j = 0; j < 8; ++j) { const f32x4 gg = gv[j]; v2u o; o.x = pk2(v[j].x * rstd * gg.x, v[j].y * rstd * gg.y); o.y = pk2(v[j].z * rstd * gg.z, v[j].w * rstd * gg.w); o8[64 * j] = o;
                if (h8) ((GAS unsigned*)(h8 + (size_t)t * DM))[64 * j + F.lane] = pg8::pack4_fp8(v[j].x * rstd * gg.x, v[j].y * rstd * gg.y, v[j].z * rstd * gg.z, v[j].w * rstd * gg.w); }
        }
    }
}
__device__ __forceinline__ void phase_qknorm(Frame& F, int l, const float* qg, const float* kg) {
    const int gw = fresh_s(F.vcu * NWAVES + F.wave), NGW = F.G * NWAVES, lane = lane_fresh();
    const float* ropec = (const float*)(F.ws + WS_ROPEC); const float* ropes = (const float*)(F.ws + WS_ROPES);
    float* qnrm = (float*)(F.ws + WS_QNRM);
    float kmax = 0.f;
    const int isk = gw & 1;
    float gn[16];
    { const float* gnp = (isk ? kg : qg) + 16 * (lane & 3);
#pragma unroll
      for (int i = 0; i < 16; ++i) gn[i] = gnp[i]; }
    const bf16* sbase = (const bf16*)(F.ws + (isk ? WS_KRAW : WS_QRAW)) + 16 * lane;
    bf16* dbase = (bf16*)(F.ws + (isk ? WS_KN : WS_QN)) + 16 * lane;
    const float sc = isk ? 1.f : QSCALE;
    for (int it0 = gw; it0 < 2 * SEQ; it0 += 4 * NGW) {
        v4u w0[4], w1[4]; f32x4 rc0[4], rc1[4], rs0[4], rs1[4];
#pragma unroll
        for (int j = 0; j < 4; ++j) { const int it = it0 + j * NGW;
            if (it < 2 * SEQ) { const int t = it >> 1; const bf16* src = sbase + (size_t)t * DATT;
                w0[j] = *(const GAS v4u*)src; w1[j] = *(const GAS v4u*)(src + 8);
                rc0[j] = *(const GAS f32x4*)(ropec + t * 8); rc1[j] = *(const GAS f32x4*)(ropec + t * 8 + 4); rs0[j] = *(const GAS f32x4*)(ropes + t * 8); rs1[j] = *(const GAS f32x4*)(ropes + t * 8 + 4); } }
#pragma unroll
        for (int j = 0; j < 4; ++j) { const int it = it0 + j * NGW;
            if (it < 2 * SEQ) { const int t = it >> 1; bf16* dst = dbase + (size_t)t * DATT;
                float x[16];
                x[0] = bflo(w0[j].x); x[1] = bfhi(w0[j].x); x[2] = bflo(w0[j].y); x[3] = bfhi(w0[j].y); x[4] = bflo(w0[j].z); x[5] = bfhi(w0[j].z); x[6] = bflo(w0[j].w); x[7] = bfhi(w0[j].w);
                x[8] = bflo(w1[j].x); x[9] = bfhi(w1[j].x); x[10] = bflo(w1[j].y); x[11] = bfhi(w1[j].y); x[12] = bflo(w1[j].z); x[13] = bfhi(w1[j].z); x[14] = bflo(w1[j].w); x[15] = bfhi(w1[j].w);
                float ss = 0.f;
#pragma unroll
                for (int i = 0; i < 16; ++i) ss += x[i] * x[i];
                ss += bperm_f(lane ^ 1, ss); ss += bperm_f(lane ^ 2, ss);
                const float rstd = rsqrtf(ss * (1.f / HD) + EPS);
#pragma unroll
                for (int i = 0; i < 16; ++i) x[i] = x[i] * rstd * gn[i];
                if ((lane & 3) == 0) {
                    const float cv[8] = {rc0[j].x, rc0[j].y, rc0[j].z, rc0[j].w, rc1[j].x, rc1[j].y, rc1[j].z, rc1[j].w}, sv[8] = {rs0[j].x, rs0[j].y, rs0[j].z, rs0[j].w, rs1[j].x, rs1[j].y, rs1[j].z, rs1[j].w};
#pragma unroll
                    for (int i = 0; i < 8; ++i) { const float c = cv[i], s_ = sv[i], x1 = x[i], x2 = x[i + 8]; x[i] = x1 * c - x2 * s_; x[i + 8] = x2 * c + x1 * s_; }
                }
                unsigned o[8]; float n2 = 0.f;
#pragma unroll
                for (int i = 0; i < 8; ++i) { o[i] = pk2(x[2 * i] * sc, x[2 * i + 1] * sc); const float a0 = bflo(o[i]), a1 = bfhi(o[i]); n2 += a0 * a0 + a1 * a1; }
                n2 += bperm_f(lane ^ 1, n2); n2 += bperm_f(lane ^ 2, n2);
                v4u o0, o1; o0.x = o[0]; o0.y = o[1]; o0.z = o[2]; o0.w = o[3]; o1.x = o[4]; o1.y = o[5]; o1.z = o[6]; o1.w = o[7];
                *(GAS v4u*)dst = o0; *(GAS v4u*)(dst + 8) = o1;
                if (isk) kmax = fmaxf(kmax, n2);
                else if ((lane & 3) == 0) qnrm[t * NHH + (lane >> 2)] = sqrtf(n2); } }
    }
    LAS float* red = (LAS float*)(F.lds + RING_OFF);
    __syncthreads();
    if ((lane & 3) == 0) red[F.wave * 16 + (lane >> 2)] = kmax;
    __syncthreads();
    if (F.wave == 0 && lane < NHH) { float m = 0.f;
#pragma unroll
        for (int w = 0; w < NWAVES; ++w) m = fmaxf(m, red[w * 16 + lane]);
        atomicMax((unsigned*)(F.ctl + CW_KMAX + l * NHH + lane), __float_as_uint(m)); }
    __syncthreads();
}
typedef float rf32x4 __attribute__((ext_vector_type(4)));
__device__ __forceinline__ void phase_norm_router(Frame& F, const float* xin, const float* g, const float* wrt, bf16* xn, float* aff) {
    const int lane = lane_fresh(), r = lane & 15, kk = lane >> 4, wave = F.wave, rg = wave & 1, kq = wave >> 1;
    LAS float* lrs = (LAS float*)(F.lds + RING_OFF);
    LAS float* part = lrs + 64;
    for (int base = fresh_s(F.vcu) * 32; base < SEQ; base += F.G * 32) {
        __syncthreads();
        rf32x4 xv[8][4];
        {
            const float* xrow = xin + (size_t)(base + 16 * rg + r) * DM + 512 * kq + 16 * kk;
            const float* wrow = wrt + (size_t)r * DM + 512 * kq + 16 * kk;
            rf32x4 acc = {0.f, 0.f, 0.f, 0.f}; float ss = 0.f;
#pragma unroll
            for (int s8 = 0; s8 < 8; ++s8) {
                rf32x4 wv[4];
#pragma unroll
                for (int i = 0; i < 4; ++i) { xv[s8][i] = *(const GAS rf32x4*)(xrow + 64 * s8 + 4 * i); wv[i] = *(const GAS rf32x4*)(wrow + 64 * s8 + 4 * i); }
#pragma unroll
                for (int i = 0; i < 4; ++i)
#pragma unroll
                    for (int j = 0; j < 4; ++j) { acc = __builtin_amdgcn_mfma_f32_16x16x4f32(xv[s8][i][j], wv[i][j], acc, 0, 0, 0); ss += xv[s8][i][j] * xv[s8][i][j]; }
            }
            LAS float* pp = part + (wave * 64 + lane) * 5;
            pp[0] = acc[0]; pp[1] = acc[1]; pp[2] = acc[2]; pp[3] = acc[3]; pp[4] = ss;
        }
        __syncthreads();
        if (wave < 2) {
            rf32x4 acc = {0.f, 0.f, 0.f, 0.f}; float ss = 0.f;
#pragma unroll
            for (int q = 0; q < 4; ++q) { const LAS float* pp = part + ((2 * q + wave) * 64 + lane) * 5; acc[0] += pp[0]; acc[1] += pp[1]; acc[2] += pp[2]; acc[3] += pp[3]; ss += pp[4]; }
            ss += bperm_f(lane ^ 16, ss); ss += bperm_f(lane ^ 32, ss);
            const float rstd = rsqrtf(ss * (1.f / DM) + EPS);
            if (lane < 16) lrs[16 * wave + lane] = rstd;
#pragma unroll
            for (int q = 0; q < 4; ++q) { const int row = 4 * kk + q; const float lg = acc[q] * bperm_f(row, rstd);
                float m = lg; m = fmaxf(m, bperm_f(lane ^ 1, m)); m = fmaxf(m, bperm_f(lane ^ 2, m)); m = fmaxf(m, bperm_f(lane ^ 4, m)); m = fmaxf(m, bperm_f(lane ^ 8, m));
                const float p = expf(lg - m); float sm = p; sm += bperm_f(lane ^ 1, sm); sm += bperm_f(lane ^ 2, sm); sm += bperm_f(lane ^ 4, sm); sm += bperm_f(lane ^ 8, sm);
                aff[(size_t)(base + 16 * wave + row) * NE + r] = p / sm; }
        }
        __syncthreads();
        { const float rstd = lrs[16 * rg + r];
          GAS v4u* o16 = (GAS v4u*)((unsigned char*)xn + (size_t)(base + 16 * rg + r) * DM + 512 * kq + 16 * kk); const GAS rf32x4* gp = (const GAS rf32x4*)(g + 512 * kq + 16 * kk);
#pragma unroll
          for (int s8 = 0; s8 < 8; ++s8) { v4u w;
#pragma unroll
              for (int i = 0; i < 4; ++i) { const rf32x4 gg = gp[16 * s8 + i]; const rf32x4 v = xv[s8][i]; const unsigned pw_ = pg8::pack4_fp8(v[0] * rstd * gg[0], v[1] * rstd * gg[1], v[2] * rstd * gg[2], v[3] * rstd * gg[3]);
                  if (i == 0) w.x = pw_; else if (i == 1) w.y = pw_; else if (i == 2) w.z = pw_; else w.w = pw_; }
              o16[4 * s8] = w; } }
    }
    __syncthreads();
}
__device__ __forceinline__ int block_excl_scan(int v, LAS int* tmp, int lane, int wave, int& total) {
    int incl = v;
#pragma unroll
    for (int o = 1; o < 64; o <<= 1) { const int n = bperm_i(lane - o, incl); if (lane >= o) incl += n; }
    __syncthreads();
    if (lane == 63) tmp[wave] = incl;
    __syncthreads();
    int woff = 0, tot = 0;
#pragma unroll
    for (int w = 0; w < NWAVES; ++w) { const int x = tmp[w]; if (w < wave) woff += x; tot += x; }
    total = tot;
    return woff + incl - v;
}
__device__ __forceinline__ void phase_topk(Frame& F, const float* aff, int* sel, int* idx, float* gwt) {
    LAS int* hist = (LAS int*)(F.lds + RING_OFF);
    LAS int* ctl = hist + NWAVES * 256;
    LAS int* tmp = ctl + 16;
    const int lane = lane_fresh(), wave = F.wave, tid = wave * 64 + lane;
    for (int e = fresh_s(F.vcu); e < NE; e += F.G) {
        unsigned key[16];
#pragma unroll
        for (int i = 0; i < 16; ++i) key[i] = __float_as_uint(aff[(size_t)(tid * 16 + i) * NE + e]);
        unsigned prefix = 0u; int need = CAP;
#pragma unroll 1
        for (int rnd = 3; rnd >= 0; --rnd) {
            const int sh = 8 * rnd; const unsigned himask = rnd == 3 ? 0u : (0xffffffffu << (sh + 8));
            __syncthreads();
            for (int i = tid; i < NWAVES * 256; i += NWAVES * 64) hist[i] = 0;
            __syncthreads();
#pragma unroll
            for (int i = 0; i < 16; ++i) if ((key[i] & himask) == prefix) __hip_atomic_fetch_add(&hist[wave * 256 + ((key[i] >> sh) & 255u)], 1, __ATOMIC_RELAXED, __HIP_MEMORY_SCOPE_WORKGROUP);
            __syncthreads();
            if (wave == 0) {
                const int b0 = 255 - 4 * lane; int h0 = 0, h1 = 0, h2 = 0, h3 = 0;
#pragma unroll
                for (int w = 0; w < NWAVES; ++w) { h0 += hist[w * 256 + b0]; h1 += hist[w * 256 + b0 - 1]; h2 += hist[w * 256 + b0 - 2]; h3 += hist[w * 256 + b0 - 3]; }
                const int mine = h0 + h1 + h2 + h3; int incl = mine;
#pragma unroll
                for (int o = 1; o < 64; o <<= 1) { const int n = bperm_i(lane - o, incl); if (lane >= o) incl += n; }
                const int before = incl - mine;
                if (before < need && need <= incl) { int c = before, b = b0, hsel = h0;
                    if (need > c + h0) { c += h0; b = b0 - 1; hsel = h1; if (need > c + h1) { c += h1; b = b0 - 2; hsel = h2; if (need > c + h2) { c += h2; b = b0 - 3; hsel = h3; } } }
                    (void)hsel; ctl[0] = (int)(prefix | ((unsigned)b << sh)); ctl[1] = need - c; }
            }
            __syncthreads();
            prefix = (unsigned)ctl[0]; need = ctl[1];
        }
        int neq = 0;
#pragma unroll
        for (int i = 0; i < 16; ++i) neq += (key[i] == prefix) ? 1 : 0;
        int tot; int eqr = block_excl_scan(neq, tmp, lane, wave, tot);
        int nsel = 0; unsigned selmask = 0u;
#pragma unroll
        for (int i = 0; i < 16; ++i) { bool s = key[i] > prefix; if (key[i] == prefix) { s = eqr < need; ++eqr; } if (s) { selmask |= 1u << i; ++nsel; } }
        int slot = block_excl_scan(nsel, tmp, lane, wave, tot);
#pragma unroll
        for (int i = 0; i < 16; ++i) { const int t = tid * 16 + i; const bool s = (selmask >> i) & 1u;
            sel[(size_t)t * NE + e] = s ? slot : -1;
            if (s) { idx[e * CAP + slot] = t; gwt[e * CAP + slot] = __uint_as_float(key[i]); ++slot; } }
    }
    __syncthreads();
}
__device__ __forceinline__ void phase_gather8(Frame& F, const unsigned char* xn8, const int* idx, unsigned char* xe8) {
    const int gw = fresh_s(F.vcu * NWAVES + F.wave), NGW = F.G * NWAVES, lane = lane_fresh();
    for (int rb = gw; rb < NE * CAP; rb += 8 * NGW) {
        const int myr = rb + (lane & 7) * NGW; const int iv = myr < NE * CAP ? idx[myr] : 0;
        v4u a[8], b[8];
#pragma unroll
        for (int j = 0; j < 8; ++j) { const int r = rb + j * NGW;
            if (r < NE * CAP) { const int t = __builtin_amdgcn_readlane(iv, j); const GAS v4u* s = (const GAS v4u*)(xn8 + (size_t)t * DM) + lane; a[j] = s[0]; b[j] = s[64]; } }
#pragma unroll
        for (int j = 0; j < 8; ++j) { const int r = rb + j * NGW;
            if (r < NE * CAP) { GAS v4u* d = (GAS v4u*)(xe8 + (size_t)r * DM) + lane; d[0] = a[j]; d[64] = b[j]; } }
    }
}
__device__ __forceinline__ void phase_gather(Frame& F, const bf16* xn, const int* idx, bf16* xe) {
    const int gw = fresh_s(F.vcu * NWAVES + F.wave), NGW = F.G * NWAVES, lane = lane_fresh();
    for (int r = gw; r < NE * CAP; r += NGW) { const int t = __builtin_amdgcn_readfirstlane(idx[r]);
        const GAS v4u* s = (const GAS v4u*)(xn + (size_t)t * DM) + lane; GAS v4u* d = (GAS v4u*)(xe + (size_t)r * DM) + lane;
#pragma unroll
        for (int j = 0; j < 4; ++j) d[64 * j] = s[64 * j]; }
}

__device__ __forceinline__ float gelu_tanh(float x) {
    const float z = 0.7978845608028654f * (x + 0.044715f * x * x * x);
    const float th = 1.f - 2.f / (1.f + __expf(2.f * z));
    return 0.5f * x * (1.f + th);
}

#ifndef USE_FAST_SSM
#define USE_FAST_SSM 1
#endif
#ifndef USE_FAST_ATTN
#define USE_FAST_ATTN 1
#endif
constexpr size_t WS_LAM16 = WS_LAMB + 512 * 1024;
constexpr size_t WS_SSMTOT = WS_LAMB;
constexpr int SSM_SROW = 264;
typedef short abf16x8 __attribute__((ext_vector_type(8)));
typedef short as16x4 __attribute__((ext_vector_type(4)));
typedef float af32x16 __attribute__((ext_vector_type(16)));
struct cf2 { float x, y; };
__device__ __forceinline__ cf2 ldc_(const LAS float* p, int i) { cf2 r; r.x = p[2 * i]; r.y = p[2 * i + 1]; return r; }
#define LDC(arr, i) ldc_((arr), (i))

__device__ __forceinline__ void ssm_tables_unit(Frame& F, const Args& a, int l, int g) {
    LAS float* lamp = (LAS float*)(F.lds + RING_OFF);
    LAS float* bb = lamp + 2 * 2 * 17 * 64;
    LAS float* cc = bb + 2 * 2 * 64 * 16;
    LAS float* kk = cc + 2 * 2 * 16 * 64;
    const int tid = F.wave * 64 + lane_fresh();
    __syncthreads();
    if (tid < 128) { const int dir = tid >> 6, p = tid & 63; const int gb = (l * 2 + dir) * NG + g, i = gb * SP + p;
        const double ar = a.in[4][i], ai = a.in[5][i], st = exp((double)a.in[6][gb]);
        const double er = exp(ar * st), lr = er * cos(ai * st), li = er * sin(ai * st);
        const double xr = lr - 1.0, xi = li, den = ar * ar + ai * ai, qr = (xr * ar + xi * ai) / den, qi = (xi * ar - xr * ai) / den;
        double pr = 1.0, pi = 0.0;
        for (int d = 0; d <= 16; ++d) { lamp[2 * ((dir * 17 + d) * 64 + p)] = (float)pr; lamp[2 * ((dir * 17 + d) * 64 + p) + 1] = (float)pi;
            if (d == 16) ((float2*)(F.ws + WS_LAM16))[i] = make_float2((float)pr, (float)pi);
            const double nr = pr * lr - pi * li, ni = pr * li + pi * lr; pr = nr; pi = ni; }
        for (int h = 0; h < SG; ++h) { const double br = a.in[7][(size_t)i * SG + h], bi = a.in[8][(size_t)i * SG + h];
            bb[2 * ((dir * 64 + p) * 16 + h)] = (float)(qr * br - qi * bi); bb[2 * ((dir * 64 + p) * 16 + h) + 1] = (float)(qr * bi + qi * br); }
    }
    for (int e = tid; e < 2048; e += NWAVES * 64) { const int dir = e >> 10, h = (e >> 6) & 15, p = e & 63; const size_t idx = ((size_t)((l * 2 + dir) * NG + g) * SG + h) * SP + p;
        cc[2 * e] = a.in[9][idx]; cc[2 * e + 1] = a.in[10][idx]; }
    __syncthreads();
    { const int lane_ = tid & 63, wv_ = tid >> 6, dir = wv_ >> 2, dq = (wv_ & 3) * 4, m = lane_ & 15, q = lane_ >> 4;
      typedef float tf32x4 __attribute__((ext_vector_type(4)));
      tf32x4 acc[4];
#pragma unroll
      for (int dd = 0; dd < 4; ++dd) acc[dd] = tf32x4{0.f, 0.f, 0.f, 0.f};
#pragma unroll 4
      for (int st = 0; st < 32; ++st) { const int p = 2 * st + (q >> 1); const bool im = q & 1;
          const cf2 c = LDC(cc, (dir * 16 + m) * 64 + p), b = LDC(bb, (dir * 64 + p) * 16 + m);
          const float bv = im ? b.y : b.x;
#pragma unroll
          for (int dd = 0; dd < 4; ++dd) { const cf2 L = LDC(lamp, (dir * 17 + dq + dd) * 64 + p);
              const float av = im ? -(c.x * L.y + c.y * L.x) : (c.x * L.x - c.y * L.y);
              acc[dd] = __builtin_amdgcn_mfma_f32_16x16x4f32(av, bv, acc[dd], 0, 0, 0); } }
#pragma unroll
      for (int dd = 0; dd < 4; ++dd)
#pragma unroll
          for (int j = 0; j < 4; ++j) kk[((dir * 16 + dq + dd) * 16 + (4 * q + j)) * 16 + m] = acc[dd][j]; }
    __syncthreads();
    unsigned* em = (unsigned*)((bf16*)(F.ws + WS_EMAT) + (size_t)(l * NG + g) * 65536);
    for (int e = tid; e < 32768; e += NWAVES * 64) { const int j = e >> 7, k = (e & 127) * 2, dir = j >> 7, ri = (j >> 6) & 1, p = j & 63, s = k >> 4, h = k & 15;
        const cf2 L = LDC(lamp, (dir * 17 + (dir ? s : 15 - s)) * 64 + p), b0 = LDC(bb, (dir * 64 + p) * 16 + h), b1 = LDC(bb, (dir * 64 + p) * 16 + h + 1);
        const float v0 = ri ? (L.x * b0.y + L.y * b0.x) : (L.x * b0.x - L.y * b0.y), v1 = ri ? (L.x * b1.y + L.y * b1.x) : (L.x * b1.x - L.y * b1.y);
        em[e] = pk2(v0, v1); }
    unsigned* wm = (unsigned*)((bf16*)(F.ws + WS_WMAT) + (size_t)(l * NG + g) * 131072);
    const float* dsk = a.in[11] + (size_t)l * DSSM + g * SG;
    for (int e = tid; e < 32768; e += NWAVES * 64) { const int n = e >> 7, kp = e & 127, t = n >> 4, h = n & 15, s = kp >> 3, h2 = 2 * (kp & 7); float v0 = 0.f, v1 = 0.f;
        if (s <= t) { const LAS float* q = kk + ((0 * 16 + (t - s)) * 16 + h) * 16 + h2; v0 += q[0]; v1 += q[1]; }
        if (s >= t) { const LAS float* q = kk + ((1 * 16 + (s - t)) * 16 + h) * 16 + h2; v0 += q[0]; v1 += q[1]; }
        if (s == t) { if (h == h2) v0 += dsk[h]; else if (h == h2 + 1) v1 += dsk[h]; }
        wm[n * 256 + kp] = pk2(v0, v1); }
    for (int e = tid; e < 32768; e += NWAVES * 64) { const int n = e >> 7, kp = e & 127, t = n >> 4, h = n & 15, dir = kp >> 6, ri = (kp >> 5) & 1, p = 2 * (kp & 31);
        const int ci = (dir * 16 + h) * 64 + p, li = (dir * 17 + (dir ? 16 - t : t + 1)) * 64 + p;
        const cf2 c0 = LDC(cc, ci), c1 = LDC(cc, ci + 1), L0 = LDC(lamp, li), L1 = LDC(lamp, li + 1);
        const float v0 = ri ? -(c0.x * L0.y + c0.y * L0.x) : (c0.x * L0.x - c0.y * L0.y), v1 = ri ? -(c1.x * L1.y + c1.y * L1.x) : (c1.x * L1.x - c1.y * L1.y);
        wm[n * 256 + 128 + kp] = pk2(v0, v1); }
    __syncthreads();
}
__device__ __forceinline__ void ssm_e_unit(Frame& F, int l, int g, int part) {
    const int lane = lane_fresh(), r32 = lane & 31, hh = lane >> 5, wm = F.wave & 3, wn = F.wave >> 2;
    const bf16* em = (const bf16*)(F.ws + WS_EMAT) + (size_t)(l * NG + g) * 65536;
    float* E = (float*)(F.ws + WS_SSME) + (size_t)g * 512 * 256;
    const int c0 = part * 128 + wm * 32;
    af32x16 acc[4];
#pragma unroll
    for (int nb = 0; nb < 4; ++nb) acc[nb] = af32x16{};
    const bf16* ap = (const bf16*)(F.ws + WS_U) + ((size_t)g * SEQ + 16 * (c0 + r32)) * SG + 8 * hh;
    LAS unsigned char* bimg = F.lds + RING_OFF;
    const int tid_ = F.wave * 64 + lane;
    abf16x8 av[16];
#pragma unroll
    for (int ks = 0; ks < 16; ++ks) av[ks] = *(const GAS abf16x8*)(ap + ks * SG);
    { const GAS v4u* src = (const GAS v4u*)em + tid_; v4u stg[16];
#pragma unroll
      for (int q = 0; q < 16; ++q) stg[q] = src[q * 512];
      __builtin_amdgcn_sched_barrier(0);
#pragma unroll
      for (int q = 0; q < 16; ++q) { const int idx = tid_ + q * 512; *(LAS v4u*)(bimg + (idx >> 5) * 528 + (idx & 31) * 16) = stg[q]; } }
    __syncthreads();
    { const LAS unsigned char* bl = bimg + (wn * 128 + r32) * 528 + hh * 16;
#pragma unroll
      for (int ks = 0; ks < 16; ++ks)
#pragma unroll
          for (int nb = 0; nb < 4; ++nb) { const abf16x8 bv = *(const LAS abf16x8*)(bl + nb * 32 * 528 + ks * 32); acc[nb] = __builtin_amdgcn_mfma_f32_32x32x16_bf16(av[ks], bv, acc[nb], 0, 0, 0); } }
    LAS float* el = (LAS float*)(F.lds + RING_OFF);
    __syncthreads();
#pragma unroll
    for (int nb = 0; nb < 4; ++nb)
#pragma unroll
        for (int i = 0; i < 16; ++i) { const int row = (i & 3) + 8 * (i >> 2) + 4 * hh; el[(wm * 32 + row) * 256 + wn * 128 + nb * 32 + r32] = acc[nb][i]; }
    __syncthreads();
    { const int dir = F.wave & 1, seg = F.wave >> 1;
        const float2 L = ((const float2*)(F.ws + WS_LAM16))[((l * 2 + dir) * NG + g) * SP + lane];
        const LAS float* ep = el + dir * 128 + lane; float* eo = E + (size_t)(part * 128) * 256 + dir * 128 + lane;
        LAS float* xs = el + 128 * 256;
        float vr[32], vi[32];
#pragma unroll
        for (int kk_ = 0; kk_ < 32; ++kk_) { const int k = 32 * seg + kk_, c = dir ? 127 - k : k; vr[kk_] = ep[c * 256]; vi[kk_] = ep[c * 256 + 64]; }
        float sr = 0.f, si = 0.f;
#pragma unroll
        for (int kk_ = 0; kk_ < 32; ++kk_) { const float nr = L.x * sr - L.y * si + vr[kk_], ni = L.x * si + L.y * sr + vi[kk_]; sr = nr; si = ni; vr[kk_] = sr; vi[kk_] = si; }
        xs[((dir * 4 + seg) * 64 + lane) * 2] = sr; xs[((dir * 4 + seg) * 64 + lane) * 2 + 1] = si;
        float pr32 = L.x, pi32 = L.y;
#pragma unroll
        for (int q = 0; q < 5; ++q) { const float nr = pr32 * pr32 - pi32 * pi32, ni = 2.f * pr32 * pi32; pr32 = nr; pi32 = ni; }
        __syncthreads();
        float cr = 0.f, ci = 0.f;
#pragma unroll
        for (int j = 0; j < 3; ++j) if (j < seg) { const float tr = xs[((dir * 4 + j) * 64 + lane) * 2], ti = xs[((dir * 4 + j) * 64 + lane) * 2 + 1];
            const float nr = pr32 * cr - pi32 * ci + tr, ni = pr32 * ci + pi32 * cr + ti; cr = nr; ci = ni; }
        float pr = L.x, pi = L.y;
#pragma unroll
        for (int kk_ = 0; kk_ < 32; ++kk_) { const int k = 32 * seg + kk_, c = dir ? 127 - k : k;
            sr = vr[kk_] + pr * cr - pi * ci; si = vi[kk_] + pr * ci + pi * cr;
            eo[(size_t)c * 256] = sr; eo[(size_t)c * 256 + 64] = si;
            const float nr = pr * L.x - pi * L.y, ni = pr * L.y + pi * L.x; pr = nr; pi = ni; }
        if (seg == 3) { float* tot = (float*)(F.ws + WS_SSMTOT) + ((size_t)g * 4 + part) * 256 + dir * 128 + lane; tot[0] = sr; tot[64] = si; }
    }
    __syncthreads();
}
__device__ __forceinline__ float gelu_tanh_f(float x) {
    const float z = 0.7978845608028654f * (x + 0.044715f * x * x * x);
    const float th = 1.f - 2.f * __builtin_amdgcn_rcpf(1.f + __builtin_amdgcn_exp2f(2.8853900817779268f * z));
    return 0.5f * x * (1.f + th);
}
constexpr int SSM_APITCH = 520;
__device__ __forceinline__ void ssm_y_unit(Frame& F, int l, int g, int part) {
    const int lane = lane_fresh(), tid = F.wave * 64 + lane, r32 = lane & 31, hh = lane >> 5;
    LAS bf16* ai = (LAS bf16*)(F.lds + RING_OFF);
    const float* E = (const float*)(F.ws + WS_SSME) + (size_t)g * 512 * 256;
    const int c0p = part * 128;
    __syncthreads();
    { const bf16* U = (const bf16*)(F.ws + WS_U) + ((size_t)g * SEQ + 16 * c0p) * SG;
#pragma unroll
      for (int q = 0; q < 8; ++q) { const int idx = tid + q * 512, c = idx >> 5, sh = idx & 31;
          const v4u w = *(const GAS v4u*)(U + (size_t)idx * 8);
          *(LAS v4u*)(ai + c * SSM_APITCH + sh * 8) = w; } }
    const bf16* bp = (const bf16*)(F.ws + WS_WMAT) + (size_t)(l * NG + g) * 131072 + (size_t)(F.wave * 32 + r32) * 512 + 8 * hh;
    abf16x8 bvA[8], bvB[8];
#define Y_LOAD(BV, kg) do { _Pragma("unroll") for (int j = 0; j < 8; ++j) BV[j] = *(const GAS abf16x8*)(bp + ((kg) * 8 + j) * 16); } while (0)
    Y_LOAD(bvA, 0);
    { const int dir = F.wave & 1, hq = F.wave >> 1;
        const float2 L = ((const float2*)(F.ws + WS_LAM16))[((l * 2 + dir) * NG + g) * SP + lane];
        float qr = L.x, qi = L.y, tr32 = 0.f, ti32 = 0.f;
#pragma unroll
        for (int q = 0; q < 7; ++q) { if (q == 5) { tr32 = qr; ti32 = qi; } const float nr = qr * qr - qi * qi, ni = 2.f * qr * qi; qr = nr; qi = ni; }
        const float* tot = (const float*)(F.ws + WS_SSMTOT) + (size_t)g * 4 * 256 + dir * 128 + lane;
        float cr = 0.f, ci = 0.f;
        float ttr[4], tti[4];
#pragma unroll
        for (int pp = 0; pp < 4; ++pp) { ttr[pp] = tot[pp * 256]; tti[pp] = tot[pp * 256 + 64]; }
        const float* ep = E + (size_t)c0p * 256 + dir * 128 + lane;
        const int k0 = 32 * hq, kend = hq == 3 ? 127 : k0 + 32;
        float ev_r[32], ev_i[32];
#pragma unroll
        for (int kk_ = 0; kk_ < 32; ++kk_) { const int k = k0 + kk_; if (k < kend) { const int src = dir ? 127 - k : k; ev_r[kk_] = ep[(size_t)src * 256]; ev_i[kk_] = ep[(size_t)src * 256 + 64]; } else { ev_r[kk_] = 0.f; ev_i[kk_] = 0.f; } }
        if (dir == 0) {
#pragma unroll
            for (int pp = 0; pp < 3; ++pp) if (pp < part) { const float nr = qr * cr - qi * ci + ttr[pp], ni = qr * ci + qi * cr + tti[pp]; cr = nr; ci = ni; } }
        else {
#pragma unroll
            for (int pp = 3; pp > 0; --pp) if (pp > part) { const float nr = qr * cr - qi * ci + ttr[pp], ni = qr * ci + qi * cr + tti[pp]; cr = nr; ci = ni; } }
        LAS bf16* so = ai + 256 + dir * 128 + lane;
        if (hq == 0) { so[(dir ? 127 : 0) * SSM_APITCH] = (bf16)f2bf(cr); so[(dir ? 127 : 0) * SSM_APITCH + 64] = (bf16)f2bf(ci); }
        float pr = L.x, pi = L.y;
#pragma unroll
        for (int i = 0; i < 3; ++i) if (i < hq) { const float nr = pr * tr32 - pi * ti32, ni = pr * ti32 + pi * tr32; pr = nr; pi = ni; }
#pragma unroll
        for (int kk_ = 0; kk_ < 32; ++kk_) { const int k = k0 + kk_;
            if (k < kend) { const int dst = dir ? 126 - k : k + 1; const float er = ev_r[kk_], ei = ev_i[kk_];
                so[dst * SSM_APITCH] = (bf16)f2bf(er + pr * cr - pi * ci); so[dst * SSM_APITCH + 64] = (bf16)f2bf(ei + pr * ci + pi * cr);
                const float nr = pr * L.x - pi * L.y, ni = pr * L.y + pi * L.x; pr = nr; pi = ni; } }
    }
    Y_LOAD(bvB, 1);
    __syncthreads();
    const LAS bf16* ap = ai + r32 * SSM_APITCH + 8 * hh;
    af32x16 acc[4];
#pragma unroll
    for (int mb = 0; mb < 4; ++mb) acc[mb] = af32x16{};
#define Y_MMA(BV, kg) do { _Pragma("unroll") for (int j = 0; j < 8; ++j) _Pragma("unroll") for (int mb = 0; mb < 4; ++mb) { \
        const abf16x8 av = *(const LAS abf16x8*)(ap + mb * 32 * SSM_APITCH + ((kg) * 8 + j) * 16); acc[mb] = __builtin_amdgcn_mfma_f32_32x32x16_bf16(av, BV[j], acc[mb], 0, 0, 0); } } while (0)
    __builtin_amdgcn_sched_barrier(0);
    Y_MMA(bvA, 0); __builtin_amdgcn_sched_barrier(0); Y_LOAD(bvA, 2); __builtin_amdgcn_sched_barrier(0);
    Y_MMA(bvB, 1); __builtin_amdgcn_sched_barrier(0); Y_LOAD(bvB, 3); __builtin_amdgcn_sched_barrier(0);
    Y_MMA(bvA, 2); __builtin_amdgcn_sched_barrier(0);
    Y_MMA(bvB, 3); __builtin_amdgcn_sched_barrier(0);
#undef Y_LOAD
#undef Y_MMA
    bf16* YS = (bf16*)(F.ws + WS_YS);
    const int n = F.wave * 32 + r32, t = n >> 4, h = n & 15;
    __syncthreads();
    LAS bf16* ot = (LAS bf16*)(F.lds + RING_OFF);
#pragma unroll
    for (int mb = 0; mb < 4; ++mb)
#pragma unroll
        for (int i = 0; i < 16; ++i) { const int row = (i & 3) + 8 * (i >> 2) + 4 * hh; ot[(16 * (mb * 32 + row) + t) * 16 + h] = (bf16)f2bf(gelu_tanh_f(acc[mb][i])); }
    __syncthreads();
#pragma unroll
    for (int q = 0; q < 8; ++q) { const int idx = tid + q * 512; const v4u w = *(const LAS v4u*)(ot + idx * 8);
        *(GAS v4u*)(YS + (size_t)(16 * c0p + (idx >> 1)) * DSSM + g * SG + (idx & 1) * 8) = w; }
    __syncthreads();
}

namespace att {
constexpr int KSLOT = 8192, VSLOT = 16384, NS = 3;
constexpr int LDS_K = 0, LDS_V = 4 * KSLOT, LDS_WS = LDS_V + NS * VSLOT, LDS_BYTES_ = LDS_WS + NWAVES * 512;
__device__ __forceinline__ int crow(int r, int hi) { return (r & 3) + 8 * (r >> 2) + 4 * hi; }
typedef short v4i16_t __attribute__((ext_vector_type(4)));
__device__ __forceinline__ as16x4 vtr(const LAS char* p) { return __builtin_bit_cast(as16x4, __builtin_amdgcn_ds_read_tr16_b64_v4i16((LAS v4i16_t*)p)); }
__device__ __forceinline__ void glds16(const void* gsrc, unsigned lds_dst) { unsigned keep;
    asm volatile("s_mov_b32 %0, m0\n\ts_mov_b32 m0, %2\n\ts_nop 0\n\tglobal_load_lds_dwordx4 %1, off\n\ts_mov_b32 m0, %0" : "=&s"(keep) : "v"(gsrc), "s"(lds_dst) : "memory"); }
template <int IMM> __device__ __forceinline__ void glds16s(const void* sbase, unsigned voff, unsigned lds_dst) { unsigned keep;
    asm volatile("s_mov_b32 %0, m0\n\ts_mov_b32 m0, %3\n\ts_nop 0\n\tglobal_load_lds_dwordx4 %1, %2 offset:%4\n\ts_mov_b32 m0, %0" : "=&s"(keep) : "v"(voff), "s"(sbase), "s"(lds_dst), "n"(IMM) : "memory"); }
__device__ __forceinline__ unsigned pkbf(float lo, float hi) { pg8::f32x2_t v = {lo, hi}; pg8::bf16x2_t b = __builtin_convertvector(v, pg8::bf16x2_t); return __builtin_bit_cast(unsigned, b); }
}
__device__ __forceinline__ void attn_unit(Frame& F, const Args& a, int l, int h, int qb) {
    using namespace att;
    const int wid = F.wave;
    LAS char* shm = (LAS char*)(F.lds + RING_OFF);
    const unsigned lds0 = (unsigned)(uintptr_t)shm;
    const int q0 = qb * 256 + wid * 32;
#define ATT_BAR() asm volatile("s_waitcnt lgkmcnt(0)\n\ts_barrier" ::: "memory")
#define ATT_BARK() asm volatile("s_waitcnt lgkmcnt(2)\n\ts_barrier" ::: "memory")
#define ATT_SB() __builtin_amdgcn_sched_barrier(0)
    for (int c = 0; c < 2; ++c) {
        const int lane = lane_fresh(), r32 = lane & 31, hi = lane >> 5;
        const int vrd = ((lane >> 4) & 1) * 32 + (lane & 3) * 8 + (4 * hi + ((lane & 15) >> 2)) * 64, krd = r32 * 128 + ((hi ^ ((r32 >> 1) & 7)) << 4);
        const int hh = 2 * h + c;
        const GAS unsigned char* kbase = F.ws + WS_KN + (size_t)(hh * 64 + 8 * wid * DATT) * 2;
        const GAS unsigned char* vbase = F.ws + WS_V + (size_t)(h * 128 + (wid >> 2) * 32 + 16 * (wid & 3) * DATT) * 2;
        const unsigned koff = (unsigned)(lane >> 3) * (DATT * 2) + (unsigned)(((lane & 7) ^ ((4 * wid + (lane >> 4)) & 7)) << 4), voff = (unsigned)(lane >> 2) * (DATT * 2) + (unsigned)(lane & 3) * 16;
#define ATT_DMA_K(t, s) glds16s<0>((const void*)(kbase + (size_t)(t) * 64 * DATT * 2), koff, (unsigned)__builtin_amdgcn_readfirstlane((int)(lds0 + LDS_K + (s) * KSLOT + wid * 1024)))
#define ATT_DMA_V0(t, s) glds16s<0>((const void*)(vbase + (size_t)(t) * 64 * DATT * 2), voff, (unsigned)__builtin_amdgcn_readfirstlane((int)(lds0 + LDS_V + (s) * VSLOT + wid * 1024)))
#define ATT_DMA_V1(t, s) glds16s<128>((const void*)(vbase + (size_t)(t) * 64 * DATT * 2), voff, (unsigned)__builtin_amdgcn_readfirstlane((int)(lds0 + LDS_V + (s) * VSLOT + (wid + 8) * 1024 - 128)))
#define ATT_DMA_V(t, s) do { const GAS unsigned char* vb_ = vbase + (size_t)(t) * 64 * DATT * 2; \
        glds16s<0>((const void*)vb_, voff, (unsigned)__builtin_amdgcn_readfirstlane((int)(lds0 + LDS_V + (s) * VSLOT + wid * 1024))); \
        glds16s<128>((const void*)vb_, voff, (unsigned)__builtin_amdgcn_readfirstlane((int)(lds0 + LDS_V + (s) * VSLOT + (wid + 8) * 1024 - 128)));   } while (0)
#define ATT_QK(P0_, P1_, s) do { const LAS char* kp_ = shm + LDS_K + (s) * KSLOT + krd; P0_ = af32x16{}; P1_ = af32x16{}; \
        _Pragma("unroll") for (int d0 = 0; d0 < 4; ++d0) { const LAS char* kq_ = (const LAS char*)((unsigned)(uintptr_t)kp_ ^ (unsigned)(d0 << 5)); const abf16x8 b0 = *(const LAS abf16x8*)(kq_), b1 = *(const LAS abf16x8*)(kq_ + 4096); \
            P0_ = __builtin_amdgcn_mfma_f32_32x32x16_bf16(b0, qr[d0], P0_, 0, 0, 0); P1_ = __builtin_amdgcn_mfma_f32_32x32x16_bf16(b1, qr[d0], P1_, 0, 0, 0); } } while (0)
        ATT_DMA_K(0, 0); ATT_DMA_V(0, 0); ATT_DMA_K(1, 1); ATT_DMA_V(1, 1); ATT_DMA_K(2, 2); ATT_DMA_K(3, 3);
        abf16x8 qr[4];
        { const bf16* Qw = (const bf16*)(F.ws + WS_QN) + (size_t)q0 * DATT + hh * 64;
#pragma unroll
          for (int d0 = 0; d0 < 4; ++d0) qr[d0] = *(const GAS abf16x8*)(Qw + (size_t)r32 * DATT + d0 * 16 + hi * 8); }
        const float kmx = __uint_as_float(__hip_atomic_load((unsigned*)(F.ctl + CW_KMAX + l * NHH + hh), RLX_AGENT));
        const float M = ((const float*)(F.ws + WS_QNRM))[(q0 + r32) * NHH + hh] * sqrtf(kmx) * 1.002f + 0.01f;
        af32x16 o[4];
#pragma unroll
        for (int d0 = 0; d0 < 4; ++d0) o[d0] = af32x16{};
        float l_reg = 0.f; int slot = 0;
        asm volatile("s_waitcnt vmcnt(0)" ::: "memory");
        ATT_BAR();
        af32x16 pA0, pA1, pB0, pB1;
        ATT_QK(pA0, pA1, 0);
        const bool use_m = __builtin_amdgcn_readfirstlane((int)(__ballot(M > 64.f) != 0ull)) != 0;
        const float M0 = use_m ? M : 0.f;
#pragma unroll
        for (int r = 0; r < 16; ++r) { pA0[r] = __builtin_amdgcn_exp2f(pA0[r] - M0); pA1[r] = __builtin_amdgcn_exp2f(pA1[r] - M0); }
        as16x4 vlo[8], vhi[8]; abf16x8 kf[4]; pg8::u32x4 pw[4];
#define VRD(f) do { vlo[(f) & 7] = vtr(vp + ((f) & 3) * 4096 + ((f) >> 2) * 1024); vhi[(f) & 7] = vtr(vp + ((f) & 3) * 4096 + ((f) >> 2) * 1024 + 512); } while (0)
#define VFR(f) ((abf16x8){vlo[(f) & 7][0], vlo[(f) & 7][1], vlo[(f) & 7][2], vlo[(f) & 7][3], vhi[(f) & 7][0], vhi[(f) & 7][1], vhi[(f) & 7][2], vhi[(f) & 7][3]})
#define PIN(x) asm volatile("" : "+v"(x))
#define KRD(i) kf[(i) & 3] = *(const LAS abf16x8*)((const LAS char*)((unsigned)(uintptr_t)kp ^ (unsigned)(((i) >> 1) << 5)) + ((i) & 1) * 4096)
#define GA(i, P, C, HN) do { VRD(i); if (HN && (i) + 2 < 8) KRD((i) + 2); ATT_SB(); \
            if (HN) { if ((i) < 2) C = __builtin_amdgcn_mfma_f32_32x32x16_bf16(kf[(i) & 3], qr[(i) >> 1], af32x16{}, 0, 0, 0); else C = __builtin_amdgcn_mfma_f32_32x32x16_bf16(kf[(i) & 3], qr[(i) >> 1], C, 0, 0, 0); } \
            if ((i) == 0) { if (t + 4 < SEQ / 64) ATT_DMA_K(t + 4, t & 3); } else if ((i) == 1) { if (t + 2 < SEQ / 64) ATT_DMA_V0(t + 2, s2); } else if ((i) == 2) { if (t + 2 < SEQ / 64) ATT_DMA_V1(t + 2, s2); } \
            sacc += P[4 * ((i) & 3)]; sacc += P[4 * ((i) & 3) + 1]; sacc += P[4 * ((i) & 3) + 2]; sacc += P[4 * ((i) & 3) + 3]; PIN(sacc); \
            if ((i) & 1) { pw[(i) >> 1].z = pkbf(P[4 * ((i) & 3)], P[4 * ((i) & 3) + 1]); pw[(i) >> 1].w = pkbf(P[4 * ((i) & 3) + 2], P[4 * ((i) & 3) + 3]); } \
            else { pw[(i) >> 1].x = pkbf(P[4 * ((i) & 3)], P[4 * ((i) & 3) + 1]); pw[(i) >> 1].y = pkbf(P[4 * ((i) & 3) + 2], P[4 * ((i) & 3) + 3]); } PIN(pw[(i) >> 1]); ATT_SB(); } while (0)
#define GB(j, C, HN) do { o[(j) & 3] = __builtin_amdgcn_mfma_f32_32x32x16_bf16(__builtin_bit_cast(abf16x8, pw[(j) >> 2]), VFR(j), o[(j) & 3], 0, 0, 0); if ((j) < 8) VRD((j) + 8); \
            if (HN) { C[(2 * (j)) & 15] = __builtin_amdgcn_exp2f(C[(2 * (j)) & 15] - MV); C[(2 * (j) + 1) & 15] = __builtin_amdgcn_exp2f(C[(2 * (j) + 1) & 15] - MV); PIN(C); } ATT_SB(); } while (0)
#define KPRE(s_) do { const LAS char* kp = shm + LDS_K + (s_) * KSLOT + krd; KRD(0); KRD(1); } while (0)
#define ATT_ITER(P0, P1, C0, C1, HN, WAITN, PRE) do { \
            asm volatile("s_waitcnt vmcnt(" #WAITN ")" ::: "memory"); ATT_BARK(); \
            const int s1 = slot == 2 ? 0 : slot + 1, s2 = slot >= 1 ? slot - 1 : 2; \
            const LAS char* kp = shm + LDS_K + ((t + 1) & 3) * KSLOT + krd; const LAS char* vp = shm + LDS_V + slot * VSLOT + vrd; \
            float sacc = 0.f; ATT_SB(); \
            GA(0, P0, C0, HN); GA(1, P0, C1, HN); GA(2, P0, C0, HN); GA(3, P0, C1, HN); GA(4, P1, C0, HN); GA(5, P1, C1, HN); GA(6, P1, C0, HN); GA(7, P1, C1, HN); \
            l_reg += sacc; \
            GB(0, C0, HN); GB(1, C0, HN); GB(2, C0, HN); GB(3, C0, HN); GB(4, C0, HN); GB(5, C0, HN); GB(6, C0, HN); GB(7, C0, HN); \
            GB(8, C1, HN); GB(9, C1, HN); GB(10, C1, HN); GB(11, C1, HN); GB(12, C1, HN); GB(13, C1, HN); GB(14, C1, HN); GB(15, C1, HN); \
            if (PRE) KPRE((t + 2) & 3); \
            slot = s1; ++t; } while (0)
        KPRE(1);
        int t = 0;
        if (!use_m) {
#define MV 0.f
            while (t < SEQ / 64 - 4) { ATT_ITER(pA0, pA1, pB0, pB1, true, 3, true); ATT_ITER(pB0, pB1, pA0, pA1, true, 3, true); }
            ATT_ITER(pA0, pA1, pB0, pB1, true, 3, true);
            ATT_ITER(pB0, pB1, pA0, pA1, true, 2, true);
            ATT_ITER(pA0, pA1, pB0, pB1, true, 2, false);
            ATT_ITER(pB0, pB1, pA0, pA1, false, 0, false);
#undef MV
        } else {
#define MV M
            while (t < SEQ / 64 - 4) { ATT_ITER(pA0, pA1, pB0, pB1, true, 3, true); ATT_ITER(pB0, pB1, pA0, pA1, true, 3, true); }
            ATT_ITER(pA0, pA1, pB0, pB1, true, 3, true);
            ATT_ITER(pB0, pB1, pA0, pA1, true, 2, true);
            ATT_ITER(pA0, pA1, pB0, pB1, true, 2, false);
            ATT_ITER(pB0, pB1, pA0, pA1, false, 0, false);
#undef MV
        }
#undef VRD
#undef VFR
#undef KRD
#undef KPRE
#undef PIN
#undef GA
#undef GB
#undef ATT_ITER
        ATT_BAR();
        {
            const int lane2 = lane_fresh(), r32b = lane2 & 31, hib = lane2 >> 5;
            LAS float* wsf = (LAS float*)(shm + LDS_WS) + wid * 128;
            l_reg += bperm_f(lane2 ^ 32, l_reg);
            if (hib == 0) wsf[r32b] = l_reg;
            asm volatile("s_waitcnt lgkmcnt(0)" ::: "memory");
            float rli[16];
#pragma unroll
            for (int r = 0; r < 16; ++r) rli[r] = __builtin_amdgcn_rcpf(wsf[crow(r, hib)]);
            const __amdgpu_buffer_rsrc_t trs = __builtin_amdgcn_make_buffer_rsrc((void*)(F.ws + WS_ATMP + ((size_t)((h * 32 + qb) * NWAVES + wid)) * 16384), 0, 16384, 0x00020000);
            const int toff = lane2 * 256;
            if (c == 0) {
#pragma unroll
                for (int d0 = 0; d0 < 4; ++d0)
#pragma unroll
                    for (int j = 0; j < 4; ++j) { v4u w; w.x = __float_as_uint(o[d0][4 * j] * rli[4 * j]); w.y = __float_as_uint(o[d0][4 * j + 1] * rli[4 * j + 1]); w.z = __float_as_uint(o[d0][4 * j + 2] * rli[4 * j + 2]); w.w = __float_as_uint(o[d0][4 * j + 3] * rli[4 * j + 3]);
                        __builtin_amdgcn_raw_buffer_store_b128(w, trs, toff + (d0 * 4 + j) * 16, 0, 0); }
                VM_WAIT();
            } else {
                const float lam = ((const float*)(F.ws + WS_SCAL))[l], li = lam_init_of(l);
                float ss[16];
#pragma unroll
                for (int r = 0; r < 16; ++r) ss[r] = 0.f;
#pragma unroll
                for (int d0 = 0; d0 < 4; ++d0)
#pragma unroll
                    for (int j = 0; j < 4; ++j) { const v4u w = __builtin_amdgcn_raw_buffer_load_b128(trs, toff + (d0 * 4 + j) * 16, 0, 0);
                        const float t0 = __uint_as_float(w.x), t1 = __uint_as_float(w.y), t2 = __uint_as_float(w.z), t3 = __uint_as_float(w.w);
                        float v;
                        v = t0 - lam * o[d0][4 * j] * rli[4 * j]; o[d0][4 * j] = v; ss[4 * j] += v * v;
                        v = t1 - lam * o[d0][4 * j + 1] * rli[4 * j + 1]; o[d0][4 * j + 1] = v; ss[4 * j + 1] += v * v;
                        v = t2 - lam * o[d0][4 * j + 2] * rli[4 * j + 2]; o[d0][4 * j + 2] = v; ss[4 * j + 2] += v * v;
                        v = t3 - lam * o[d0][4 * j + 3] * rli[4 * j + 3]; o[d0][4 * j + 3] = v; ss[4 * j + 3] += v * v; }
#pragma unroll
                for (int r = 0; r < 16; ++r) { float s = ss[r]; s += bperm_f(lane2 ^ 1, s); s += bperm_f(lane2 ^ 2, s); s += bperm_f(lane2 ^ 4, s); s += bperm_f(lane2 ^ 8, s); s += bperm_f(lane2 ^ 16, s);
                    ss[r] = rsqrtf(s * (1.f / 128.f) + EPS) * (1.f - li); }
                const float* sg = a.in[19] + (size_t)l * 128 + r32b;
                const __amdgpu_buffer_rsrc_t yrs = __builtin_amdgcn_make_buffer_rsrc((void*)((bf16*)(F.ws + WS_YA) + (size_t)q0 * DATT + h * 128), 0, 32 * DATT * 2, 0x00020000);
                const int yoff = r32b * 2 + hib * 4 * DATT * 2;
#pragma unroll
                for (int d0 = 0; d0 < 4; ++d0) { const float gg = sg[d0 * 32];
#pragma unroll
                    for (int r = 0; r < 16; ++r) __builtin_amdgcn_raw_buffer_store_b16((short)f2bf(o[d0][r] * ss[r] * gg), yrs, yoff + ((r & 3) + 8 * (r >> 2)) * DATT * 2 + d0 * 64, 0, 0); }
            }
        }
    }
#undef ATT_DMA_K
#undef ATT_DMA_V
#undef ATT_DMA_V0
#undef ATT_DMA_V1
#undef ATT_QK
#undef ATT_BAR
#undef ATT_BARK
#undef ATT_SB
}

enum { PH_P0 = 0, PH_L0 = 1, PH_PER_L = 12, PH_FINAL = PH_L0 + DEPTH * PH_PER_L, PH_COUNT = PH_FINAL + 1 };
enum { K_NORM1 = 0, K_INPROJ, K_QKNORM, K_ATTN, K_GLU, K_MERGE, K_OUT, K_NORM2, K_TOPK, K_GATHER, K_MOE1, K_MOE2 };

__global__ void __launch_bounds__(NWAVES * 64, 2) mk_fwd(Args args) {
    extern __shared__ __attribute__((aligned(16))) unsigned char lds[];
    Frame F;
    F.lds = (LAS unsigned char*)lds;
    F.MISC = (volatile LAS unsigned*)(F.lds + MISC_OFF);
    F.wave = __builtin_amdgcn_readfirstlane((int)threadIdx.x >> 6);
    F.G = gridDim.x; { const int bx = blockIdx.x; F.vcu = (F.G % 8 == 0) ? (bx % 8) * (F.G / 8) + bx / 8 : bx; }
    F.ws = (GAS unsigned char*)args.ws; F.ctl = (gu32*)(F.ws + WS_CTL); F.out = (GAS float*)args.out;
    for (int u = (int)threadIdx.x; u < (LDS_BYTES - LDSCTL_OFF) / 4; u += NWAVES * 64) ((LAS unsigned*)(F.lds + LDSCTL_OFF))[u] = 0u;
    __syncthreads();
    XcdBarrier bar = xcd_barrier_post((unsigned*)(F.ctl + CW_BAR) + args.bar_idx * XCD_BAR_WORDS, F.MISC + 8, F.wave == 0 ? 1u : 0u);
#define FRESH() do { GAS unsigned char* w_ = (GAS unsigned char*)args.ws; GAS float* o_ = (GAS float*)args.out; asm volatile("" : "+s"(w_), "+s"(o_)); F.ws = w_; F.ctl = (gu32*)(w_ + WS_CTL); F.out = o_; } while (0)
#define HN ((bf16*)(F.ws + WS_HN))
#define XB ((float*)(F.ws + WS_XB))
#define XA ((float*)F.out)
#define YE ((bf16*)(F.ws + WS_YE))
#define SEL ((int*)(F.ws + WS_SEL))
#define IDX ((int*)(F.ws + WS_IDX))
#define GW ((float*)(F.ws + WS_GW))
#define AFF ((float*)(F.ws + WS_AFF))
    const int lo = args.ph_lo, hi = args.ph_hi;
#define IN(k) (lo <= (k) && (k) < hi)
#define SEAM(k) do { if (IN(k) && IN((k) + 1)) xcd_barrier(bar); } while (0)

    if (IN(PH_P0)) { FRESH(); p0_prologue(F, args); FRESH(); phase_norm_rows(F, args.in[0], nullptr, nullptr, nullptr, args.in[1], HN, (unsigned char*)(F.ws + WS_H8)); SEAM(PH_P0); }

#pragma nounroll
    for (int l = 0; l < DEPTH; ++l) {
        const int pb = PH_L0 + l * PH_PER_L;
        if (IN(pb + K_NORM1)) {
            FRESH();
            if (l > 0) { phase_norm_rows(F, XA, XB, YE, SEL, args.in[1] + (size_t)l * DM, HN, (unsigned char*)(F.ws + WS_H8)); SEAM(pb + K_NORM1); }
        }
        if (IN(pb + K_INPROJ)) {
            FRESH();
            { pg8::Gemm g{HN, (const bf16*)(F.ws + WS_WIN) + (size_t)l * INC * DM, SEQ, 4096, DM}; pg8::StaticOrder S; S.init(SEQ, 4096, F.G, (int)blockIdx.x);
              pg8::EpiInProj E{(bf16*)(F.ws + WS_U), (bf16*)(F.ws + WS_QRAW), (bf16*)(F.ws + WS_KRAW), (bf16*)(F.ws + WS_V), (bf16*)(F.ws + WS_GATE), args.in[3] + (size_t)l * 2 * DM};
              pg8::gemm_phase<pg8::EpiInProj, pg8::StaticOrder, PG8_ALIGN, PG8_SP2>(F.lds + RING_OFF, g, S, E, F.wave); }
            VM_WAIT(); __syncthreads();
            { pg8::Gemm g{(const bf16*)(F.ws + WS_H8), (const bf16*)(F.ws + WS_WIN + (size_t)l * INC * DM * 2 + WIN8_OFF), SEQ, 4096, DM / 2}; pg8::StaticOrder S; S.init(SEQ, 4096, F.G, (int)blockIdx.x);
              pg8::EpiGateF8 E{(bf16*)(F.ws + WS_GATE), args.in[3] + (size_t)l * 2 * DM};
              pg8::gemm_phase<pg8::EpiGateF8, pg8::StaticOrder, false, PG8_SP2, true>(F.lds + RING_OFF, g, S, E, F.wave); }
            SEAM(pb + K_INPROJ);
        }
        if (IN(pb + K_QKNORM)) {
            FRESH();
            phase_qknorm(F, l, args.in[13] + l * HD, args.in[14] + l * HD);
#if USE_FAST_SSM
            for (int u = fresh_s(F.vcu); u < NG * 4; u += F.G) ssm_e_unit(F, l, u >> 2, u & 3);
#endif
            SEAM(pb + K_QKNORM);
        }
        if (IN(pb + K_ATTN)) {
#if USE_FAST_ATTN
            for (int u = fresh_s(F.vcu); u < NHEAD * 32; u += F.G) attn_unit(F, args, l, u >> 5, u & 31);
#endif
#if USE_FAST_SSM
            for (int u = fresh_s(F.vcu); u < NG * 4; u += F.G) ssm_y_unit(F, l, u >> 2, u & 3);
#endif
            SEAM(pb + K_ATTN);
        }
        if (IN(pb + K_GLU)) {
            FRESH();
            { const int eend = l == 0 ? P0_END_GLU0 : P0_END_GLU1, it1 = P0_I_TOTAL - eend * P0_I_PER_E, it0 = it1 - P0_DEF_GLU * P0_I_PER_E;
              constexpr int NT_GLU = (SEQ / 256) * (DSSM / 256);
              if (F.G > NT_GLU) { const int b = fresh_s((int)blockIdx.x); if (b >= NT_GLU) convert_items<false>(F, args, it0, it1, (b - NT_GLU) * NWAVES + F.wave, (F.G - NT_GLU) * NWAVES); }
              else convert_items<false>(F, args, it0, it1, fresh_s(F.vcu * NWAVES + F.wave), F.G * NWAVES); }
            FRESH();
            pg8::Gemm g{(const bf16*)(F.ws + WS_YS), (const bf16*)(F.ws + WS_WGLU) + (size_t)l * DSSM * DSSM, SEQ, DSSM, DSSM}; pg8::StaticOrder S; S.init(SEQ, DSSM, F.G, (int)blockIdx.x);
            pg8::EpiGlu E{(const bf16*)(F.ws + WS_YS), (bf16*)(F.ws + WS_YS2)};
            pg8::gemm_phase<pg8::EpiGlu, pg8::StaticOrder, PG8_ALIGN, PG8_SP2>(F.lds + RING_OFF, g, S, E, F.wave);
            SEAM(pb + K_GLU);
        }
        if (IN(pb + K_MERGE)) {
            FRESH();
            { pg8::Gemm g{(const bf16*)(F.ws + WS_YS2), (const bf16*)(F.ws + WS_WBS) + (size_t)l * DM * DSSM, SEQ, DM, DSSM}; pg8::StaticOrder S; S.init(SEQ, DM, F.G, (int)blockIdx.x);
              pg8::EpiMerge<true> E{(const bf16*)(F.ws + WS_GATE), (bf16*)(F.ws + WS_MERGED)};
              pg8::gemm_phase<pg8::EpiMerge<true>, pg8::StaticOrder, PG8_ALIGN, PG8_SP2>(F.lds + RING_OFF, g, S, E, F.wave); }
            VM_WAIT(); __syncthreads();
            { pg8::Gemm g{(const bf16*)(F.ws + WS_YA), (const bf16*)(F.ws + WS_WBA) + (size_t)l * DM * DATT, SEQ, DM, DATT}; pg8::StaticOrder S; S.init(SEQ, DM, F.G, (int)blockIdx.x);
              pg8::EpiMerge<false> E{(const bf16*)(F.ws + WS_GATE), (bf16*)(F.ws + WS_MERGED)};
              pg8::gemm_phase<pg8::EpiMerge<false>, pg8::StaticOrder, PG8_ALIGN, PG8_SP2>(F.lds + RING_OFF, g, S, E, F.wave); }
            SEAM(pb + K_MERGE);
        }
        if (IN(pb + K_OUT)) {
            FRESH();
            pg8::Gemm g{(const bf16*)(F.ws + WS_MERGED), (const bf16*)(F.ws + WS_WOUT) + (size_t)l * DM * DM, SEQ, DM, DM}; pg8::StaticOrder S; S.init(SEQ, DM, F.G, (int)blockIdx.x);
            pg8::EpiOutRes E{l == 0 ? args.in[0] : (const float*)XB, XA};
            pg8::gemm_phase<pg8::EpiOutRes, pg8::StaticOrder, PG8_ALIGN, PG8_SP2>(F.lds + RING_OFF, g, S, E, F.wave);
            SEAM(pb + K_OUT);
        }
        if (IN(pb + K_NORM2)) {
            FRESH();
            phase_norm_router(F, XA, args.in[23] + (size_t)l * DM, (const float*)(F.ws + WS_WRT) + (size_t)l * NE * DM, HN, AFF);
            SEAM(pb + K_NORM2);
        }
        if (IN(pb + K_TOPK)) { FRESH();
            { const int eend = l == 0 ? P0_END_TOPK0 : P0_END_TOPK1, it1 = P0_I_TOTAL - eend * P0_I_PER_E, it0 = it1 - P0_DEF_TOPK * P0_I_PER_E;
              if (F.G > NE) { const int v = fresh_s(F.vcu); if (v >= NE) convert_items<false>(F, args, it0, it1, (v - NE) * NWAVES + F.wave, (F.G - NE) * NWAVES); }
              else convert_items<false>(F, args, it0, it1, fresh_s(F.vcu * NWAVES + F.wave), F.G * NWAVES); }
            FRESH(); phase_topk(F, AFF, SEL, IDX, GW); SEAM(pb + K_TOPK); }
        if (IN(pb + K_GATHER)) { FRESH(); phase_gather8(F, (const unsigned char*)HN, IDX, (unsigned char*)(F.ws + WS_XE)); SEAM(pb + K_GATHER); }
        if (IN(pb + K_MOE1)) {
            FRESH();
            pg8::Gemm g{(const bf16*)(F.ws + WS_XE), (const bf16*)(F.ws + WS_WGU + (size_t)l * NE * 2048 * 2048), NE * CAP, 2048, DM / 2}; pg8::GroupedOrder S; S.init(8, F.G, F.vcu);
            pg8::EpiMoe1F8 E{(unsigned char*)(F.ws + WS_HE)};
            pg8::gemm_phase<pg8::EpiMoe1F8, pg8::GroupedOrder, PG8_ALIGN, PG8_SP2, true>(F.lds + RING_OFF, g, S, E, F.wave);
            SEAM(pb + K_MOE1);
        }
        if (IN(pb + K_MOE2)) {
            FRESH();
            pg8::Gemm g{(const bf16*)(F.ws + WS_HE), (const bf16*)(F.ws + WS_WD + (size_t)l * NE * 2048 * 1024), NE * CAP, DM, DE / 2}; pg8::GroupedOrder S; S.init(8, F.G, F.vcu);
            pg8::EpiMoe2F8 E{YE, GW};
            pg8::gemm_phase<pg8::EpiMoe2F8, pg8::GroupedOrder, PG8_ALIGN, PG8_SP2, true>(F.lds + RING_OFF, g, S, E, F.wave);
            SEAM(pb + K_MOE2);
        }
    }
    if (IN(PH_FINAL)) { FRESH(); }
    if (IN(PH_FINAL)) phase_norm_rows(F, XA, XA, YE, SEL, nullptr, nullptr);
#undef IN
#undef SEAM
#undef FRESH
#undef HN
#undef XB
#undef XA
#undef YE
#undef SEL
#undef IDX
#undef GW
#undef AFF
}


#ifndef DBG_STOP
#define DBG_STOP 0
#endif
#if DBG_STOP
__global__ void dbg_fold(float* out, unsigned char* ws, int stage) {
    const size_t n = (size_t)SEQ * DM;
    for (size_t i = (size_t)blockIdx.x * blockDim.x + threadIdx.x; i < n; i += (size_t)gridDim.x * blockDim.x) {
        float v = 0.f; const size_t h = i & ((size_t)SEQ * 1024 - 1);
        if (stage == 1) { v = bf2f(((const bf16*)(ws + WS_GATE))[i]) + bf2f(((const bf16*)(ws + WS_GATE))[i + n]) + bf2f(((const bf16*)(ws + WS_U))[h]) + bf2f(((const bf16*)(ws + WS_V))[h]) + bf2f(((const bf16*)(ws + WS_QRAW))[h]) + bf2f(((const bf16*)(ws + WS_KRAW))[h]); }
        if (stage == 2) { v = bf2f(((const bf16*)(ws + WS_QN))[h]) + bf2f(((const bf16*)(ws + WS_KN))[h]) + bf2f(((const bf16*)(ws + WS_YS))[h]) + bf2f(((const bf16*)(ws + WS_YA))[h]); }
        if (stage == 3) { v = out[i] + bf2f(((const bf16*)(ws + WS_YS2))[h]) + bf2f(((const bf16*)(ws + WS_MERGED))[i]); }
        if (stage == 4) { v = bf2f(((const bf16*)(ws + WS_HN))[i]) + ((const float*)(ws + WS_AFF))[i & (SEQ * 16 - 1)] + (float)((const int*)(ws + WS_IDX))[i & 16383] + ((const float*)(ws + WS_GW))[i & 16383] + bf2f(((const bf16*)(ws + WS_HE))[i]) + bf2f(((const bf16*)(ws + WS_YE))[i]) + bf2f(((const bf16*)(ws + WS_YE))[i + n]); }
        out[i] = v;
    }
}
#endif

extern "C" void kernel_launch(void* const* d_in, const int* in_sizes, int n_in, void* d_out, int out_size, void* d_ws, size_t ws_size, hipStream_t stream) {
    static int grid = 0;
    if (grid == 0) {
        if (n_in != 28 || in_sizes[0] != SEQ * DM || out_size != SEQ * DM || ws_size < WS_END) { fprintf(stderr, "kernel_launch: unexpected problem shape / workspace (%d inputs, ws %zu)\n", n_in, ws_size); grid = -1; return; }
        int dev = 0, cus = 0;
        if (hipGetDevice(&dev) != hipSuccess || hipDeviceGetAttribute(&cus, hipDeviceAttributeMultiprocessorCount, dev) != hipSuccess) { grid = -1; return; }
        if (hipFuncSetAttribute((const void*)mk_fwd, hipFuncAttributeMaxDynamicSharedMemorySize, LDS_BYTES) != hipSuccess) { fprintf(stderr, "kernel_launch: hipFuncSetAttribute failed\n"); grid = -1; return; }
        int per_cu = 0;
        if (hipOccupancyMaxActiveBlocksPerMultiprocessor(&per_cu, (const void*)mk_fwd, NWAVES * 64, LDS_BYTES) != hipSuccess || per_cu < 1) fprintf(stderr, "kernel_launch: occupancy query says %d\n", per_cu);
        (void)hipGetLastError();
        grid = cus;
    }
    if (grid < 0) return;
    (void)hipMemsetAsync((char*)d_ws + WS_CTL, 0, CTL_ZERO_BYTES, stream);
    Args a{};
    for (int i = 0; i < 28; ++i) a.in[i] = (const float*)d_in[i];
    a.out = (float*)d_out; a.ws = (unsigned char*)d_ws;
    int nl = 0;
    auto run = [&](int lo, int hi) { a.ph_lo = lo; a.ph_hi = hi; a.bar_idx = nl++; a.pad = 0; hipLaunchKernelGGL(mk_fwd, dim3(grid), dim3(NWAVES * 64), LDS_BYTES, stream, a); };
    unsigned char* ws = (unsigned char*)d_ws;
#ifndef MK_PER_PHASE
#define MK_PER_PHASE 0
#endif
#if !MK_PER_PHASE
    run(PH_P0, PH_COUNT);
#else
    run(PH_P0, PH_P0 + 1);
    for (int l = 0; l < DEPTH; ++l) {
        const int pb = PH_L0 + l * PH_PER_L;
        run(pb + K_NORM1, pb + K_NORM1 + 1); run(pb + K_INPROJ, pb + K_INPROJ + 1);
#if DBG_STOP == 1
        hipLaunchKernelGGL(dbg_fold, dim3(2048), dim3(256), 0, stream, (float*)d_out, ws, 1); return;
#endif
        run(pb + K_QKNORM, pb + K_QKNORM + 1);
        run(pb + K_ATTN, pb + K_ATTN + 1);
#if DBG_STOP == 2
        hipLaunchKernelGGL(dbg_fold, dim3(2048), dim3(256), 0, stream, (float*)d_out, ws, 2); return;
#endif
        for (int k = K_GLU; k <= K_OUT; ++k) run(pb + k, pb + k + 1);
#if DBG_STOP == 3
        hipLaunchKernelGGL(dbg_fold, dim3(2048), dim3(256), 0, stream, (float*)d_out, ws, 3); return;
#endif
        for (int k = K_NORM2; k <= K_MOE2; ++k) run(pb + k, pb + k + 1);
#if DBG_STOP == 4
        hipLaunchKernelGGL(dbg_fold, dim3(2048), dim3(256), 0, stream, (float*)d_out, ws, 4); return;
#endif
    }
    run(PH_FINAL, PH_FINAL + 1);
#endif
}
```
